# Optimizing an MI355X kernel written in HIP

```python
import math
import jax, jax.numpy as jnp
from jax import lax
import numpy as np

D_MODEL = 1024
BATCH = 16
SEQ = 2048
DEPTH = 2

HEAD_DIM = 64
A_HEADS = 6
A_KV_HEADS = 2
B_HEADS = 6
C_HEADS = 4
C_KV_HEADS = 2
MIX_WIDTH = HEAD_DIM * (A_HEADS + B_HEADS + C_HEADS)
PROJ_WIDTHS = (A_HEADS * HEAD_DIM, A_KV_HEADS * HEAD_DIM, A_KV_HEADS * HEAD_DIM,
               B_HEADS * HEAD_DIM, B_HEADS * HEAD_DIM, B_HEADS * HEAD_DIM,
               C_HEADS * HEAD_DIM, C_KV_HEADS * HEAD_DIM, C_KV_HEADS * HEAD_DIM)
PROJ_WIDTH = sum(PROJ_WIDTHS)
ROPE_THETA = 10000.0
GRID_W = 64
Q_BLOCK = 128
DILATED_PATTERNS = ((128, 1), (512, 4), (2048, 16))
LOCAL_HALF_WINDOW = 128
LOCAL_BLOCK = 128
PEER_HEADS = 8
N_KEYS = 128
N_EXPERTS = N_KEYS * N_KEYS
PEER_TOPK = 16
PEER_DK = 128
PEER_CHUNK = 128
NORM_EPS = 1e-6
NEG_INF = -1e30
ATTN_SCALE = HEAD_DIM ** -0.5

kernel_name = "hybrid_parallel_heads_peer_encoder"


def _rms(x):
    xf = x.astype(jnp.float32)
    y = xf * lax.rsqrt(jnp.mean(xf * xf, axis=-1, keepdims=True) + NORM_EPS)
    return y.astype(x.dtype)


def rms_norm(x, g):
    return _rms(x) * g.astype(x.dtype)


def _inv_freq(dim):
    return ROPE_THETA ** (-jnp.arange(0, dim, 2, dtype=jnp.float32) / dim)


def _rope(x, ang):
    half = x.shape[-1] // 2
    c = jnp.cos(ang)[None, :, None, :].astype(x.dtype)
    s = jnp.sin(ang)[None, :, None, :].astype(x.dtype)
    x1, x2 = x[..., :half], x[..., half:]
    return jnp.concatenate([x1 * c - x2 * s, x1 * s + x2 * c], axis=-1)


def rope_1d(x):
    pos = jnp.arange(x.shape[1], dtype=jnp.float32)
    return _rope(x, pos[:, None] * _inv_freq(HEAD_DIM)[None, :])


def rope_axial(x):
    seq = x.shape[1]
    rows = seq // GRID_W
    row = jnp.repeat(jnp.arange(rows, dtype=jnp.float32), GRID_W)
    col = jnp.tile(jnp.arange(GRID_W, dtype=jnp.float32), rows)
    half = HEAD_DIM // 2
    f = _inv_freq(half)
    return jnp.concatenate([_rope(x[..., :half], row[:, None] * f[None, :]),
                            _rope(x[..., half:], col[:, None] * f[None, :])], axis=-1)


def full_gqa(q, k, v):
    bsz, seq, h, dh = q.shape
    kv = k.shape[2]
    g = h // kv
    nb = seq // Q_BLOCK
    qb = q.reshape(bsz, nb, Q_BLOCK, kv, g, dh).transpose(1, 0, 2, 3, 4, 5)

    def block(qi):
        s = jnp.einsum('bqkgd,bskd->bkgqs', qi, k).astype(jnp.float32) * ATTN_SCALE
        p = jax.nn.softmax(s, axis=-1)
        return jnp.einsum('bkgqs,bskd->bqkgd', p.astype(v.dtype), v)

    o = lax.map(block, qb)
    return o.transpose(1, 0, 2, 3, 4, 5).reshape(bsz, seq, h, dh)


def banded_attn(q, k, v, half_window, block, sink=None):
    n, length, h, dh = q.shape
    kv = k.shape[2]
    g = h // kv
    nb = -(-length // block)
    lp = nb * block
    pad = lp - length
    qp = jnp.pad(q, ((0, 0), (0, pad), (0, 0), (0, 0))).reshape(n, nb, block, kv, g, dh)

    def kv_blocks(t):
        tp = jnp.pad(t, ((0, 0), (block, pad + block), (0, 0), (0, 0))).reshape(n, nb + 2, block, kv, dh)
        return jnp.concatenate([tp[:, :-2], tp[:, 1:-1], tp[:, 2:]], axis=2)

    kb, vb = kv_blocks(k), kv_blocks(v)
    qi = jnp.arange(lp).reshape(nb, block)
    kj = (jnp.arange(nb)[:, None] - 1) * block + jnp.arange(3 * block)[None, :]
    mask = ((jnp.abs(qi[:, :, None] - kj[:, None, :]) <= half_window)
            & (kj[:, None, :] >= 0) & (kj[:, None, :] < length))
    s = jnp.einsum('nbqkgd,nbckd->nbkgqc', qp, kb).astype(jnp.float32) * ATTN_SCALE
    s = jnp.where(mask[None, :, None, None], s, NEG_INF)
    m = jnp.max(s, axis=-1)
    if sink is not None:
        sink_b = sink.astype(jnp.float32).reshape(1, 1, kv, g, 1)
        m = jnp.maximum(m, sink_b)
    p = jnp.exp(s - m[..., None])
    l = jnp.sum(p, axis=-1)
    if sink is not None:
        l = l + jnp.exp(sink_b - m)
    o = jnp.einsum('nbkgqc,nbckd->nbqkgd', p.astype(vb.dtype), vb).astype(jnp.float32)
    o = o / l.transpose(0, 1, 4, 2, 3)[..., None]
    lse = (m + jnp.log(l)).transpose(0, 1, 4, 2, 3).reshape(n, lp, h)
    o = o.reshape(n, lp, h, dh)
    return o[:, :length].astype(q.dtype), lse[:, :length]


def dilated_attn(q, k, v):
    bsz, seq, h, dh = q.shape
    outs, lses = [], []
    for window, r in DILATED_PATTERNS:
        length = seq // r
        half = window // (2 * r)

        def to_sub(t):
            return t.reshape(bsz, length, r, h, dh).transpose(0, 2, 1, 3, 4).reshape(bsz * r, length, h, dh)

        o, lse = banded_attn(to_sub(q), to_sub(k), to_sub(v), half, half)
        outs.append(o.reshape(bsz, r, length, h, dh).transpose(0, 2, 1, 3, 4).reshape(bsz, seq, h, dh))
        lses.append(lse.reshape(bsz, r, length, h).transpose(0, 2, 1, 3).reshape(bsz, seq, h))
    alpha = jax.nn.softmax(jnp.stack(lses, axis=0), axis=0)
    o = jnp.sum(alpha[..., None] * jnp.stack(outs, axis=0).astype(jnp.float32), axis=0)
    return o.astype(q.dtype)


def peer_ffn(h, wq, keys, u, v):
    bsz, seq, d = h.shape
    hc = h.reshape((bsz * seq) // PEER_CHUNK, PEER_CHUNK, d)

    def chunk(xc):
        q = (xc @ wq).reshape(PEER_CHUNK, PEER_HEADS, 2, PEER_DK // 2)
        s = jnp.einsum('chpd,hpnd->chpn', q, keys).astype(jnp.float32)
        sv, si = lax.top_k(s, PEER_TOPK)
        cand = sv[:, :, 0, :, None] + sv[:, :, 1, None, :]
        cidx = si[:, :, 0, :, None] * N_KEYS + si[:, :, 1, None, :]
        cand = cand.reshape(PEER_CHUNK, PEER_HEADS, PEER_TOPK * PEER_TOPK)
        cidx = cidx.reshape(PEER_CHUNK, PEER_HEADS, PEER_TOPK * PEER_TOPK)
        best, pos = lax.top_k(cand, PEER_TOPK)
        idx = jnp.take_along_axis(cidx, pos, axis=-1)
        gate = jax.nn.softmax(best, axis=-1)
        ue = jnp.take(u, idx, axis=0)
        act = jax.nn.gelu(jnp.einsum('cd,chkd->chk', xc, ue).astype(jnp.float32), approximate=False) * gate
        ve = jnp.take(v, idx, axis=0)
        return jnp.einsum('chk,chkd->cd', act.astype(xc.dtype), ve)

    return lax.map(chunk, hc).reshape(bsz, seq, d)


def setup_inputs(seed: int = 0) -> dict:
    key = jax.random.key(seed)
    ks = jax.random.split(key, 12)
    f32 = jnp.float32
    nrm = lambda k, shape: jax.random.normal(k, shape, dtype=f32)
    return {
        "x": nrm(ks[0], (BATCH, SEQ, D_MODEL)),
        "attn_norm": 1.0 + 0.02 * nrm(ks[1], (DEPTH, D_MODEL)),
        "w_in": nrm(ks[2], (DEPTH, D_MODEL, PROJ_WIDTH)) * D_MODEL ** -0.5,
        "qk_gain": 1.0 + 0.02 * nrm(ks[3], (DEPTH, 3, 2, HEAD_DIM)),
        "sink_logits": 0.5 * nrm(ks[4], (DEPTH, C_HEADS)),
        "out_norm": 1.0 + 0.02 * nrm(ks[5], (DEPTH, MIX_WIDTH)),
        "w_out": nrm(ks[6], (DEPTH, MIX_WIDTH, D_MODEL)) * MIX_WIDTH ** -0.5,
        "ffn_norm": 1.0 + 0.02 * nrm(ks[7], (DEPTH, D_MODEL)),
        "peer_wq": nrm(ks[8], (DEPTH, D_MODEL, PEER_HEADS * PEER_DK)) * D_MODEL ** -0.5,
        "peer_keys": nrm(ks[9], (DEPTH, PEER_HEADS, 2, N_KEYS, PEER_DK // 2)) * (PEER_DK // 2) ** -0.5,
        "peer_u": nrm(ks[10], (DEPTH, N_EXPERTS, D_MODEL)) * D_MODEL ** -0.5,
        "peer_v": nrm(ks[11], (DEPTH, N_EXPERTS, D_MODEL)) * PEER_HEADS ** -0.5,
    }


def reference(x, attn_norm, w_in, qk_gain, sink_logits, out_norm, w_out, ffn_norm,
              peer_wq, peer_keys, peer_u, peer_v):
    bsz, seq, _ = x.shape
    bounds = [int(b) for b in np.cumsum(PROJ_WIDTHS)[:-1]]

    def heads(t):
        return t.reshape(bsz, seq, -1, HEAD_DIM)

    for layer in range(DEPTH):
        h = rms_norm(x, attn_norm[layer])
        proj = jnp.einsum('bsd,dp->bsp', h, w_in[layer])
        qa, ka, va, qb, kb, vb, qc, kc, vc = jnp.split(proj, bounds, axis=-1)
        g = qk_gain[layer]
        qa = rope_axial(rms_norm(heads(qa), g[0, 0]))
        ka = rope_axial(rms_norm(heads(ka), g[0, 1]))
        oa = full_gqa(qa, ka, heads(va))
        qb = rope_1d(rms_norm(heads(qb), g[1, 0]))
        kb = rope_1d(rms_norm(heads(kb), g[1, 1]))
        ob = dilated_attn(qb, kb, heads(vb))
        qc = rope_1d(rms_norm(heads(qc), g[2, 0]))
        kc = rope_1d(rms_norm(heads(kc), g[2, 1]))
        oc, _ = banded_attn(qc, kc, heads(vc), LOCAL_HALF_WINDOW, LOCAL_BLOCK, sink_logits[layer])
        mix = jnp.concatenate([_rms(oa.reshape(bsz, seq, -1)),
                               _rms(ob.reshape(bsz, seq, -1)),
                               _rms(oc.reshape(bsz, seq, -1))], axis=-1) * out_norm[layer].astype(x.dtype)
        x = x + jnp.einsum('bsm,md->bsd', mix, w_out[layer])
        x = x + peer_ffn(rms_norm(x, ffn_norm[layer]), peer_wq[layer], peer_keys[layer],
                         peer_u[layer], peer_v[layer])
    return x
```

```cpp
#include <hip/hip_runtime.h>
#include <cstdio>
#include <cstdint>
#include <cmath>

constexpr int BATCH = 16, SEQ = 2048, DM = 1024, DEPTH = 2;
constexpr int MTOK = BATCH * SEQ;
constexpr int PW = 2304;
constexpr int HD = 64;
constexpr int NKEYS = 128, PEER_H = 8, TOPK = 16, NEXP = NKEYS * NKEYS;
constexpr float EPS = 1e-6f;
constexpr int C_QA = 0, C_KA = 384, C_VA = 512, C_QB = 640, C_KB = 1024, C_VB = 1408, C_QC = 1792, C_KC = 2048, C_VC = 2176;

__device__ __forceinline__ float wave_sum(float v) {
#pragma unroll
    for (int o = 1; o < 64; o <<= 1) v += __shfl_xor(v, o);
    return v;
}

__global__ void __launch_bounds__(256) nk_rmsnorm(const float* __restrict__ x, const float* __restrict__ g, float* __restrict__ out, int rows) {
    const int wave = (blockIdx.x * 256 + threadIdx.x) >> 6, lane = threadIdx.x & 63;
    if (wave >= rows) return;
    const float4* xr = (const float4*)(x + (size_t)wave * DM);
    float4 v[4]; float s = 0.f;
#pragma unroll
    for (int j = 0; j < 4; ++j) { v[j] = xr[lane + 64 * j]; s += v[j].x * v[j].x + v[j].y * v[j].y + v[j].z * v[j].z + v[j].w * v[j].w; }
    s = wave_sum(s);
    const float rs = rsqrtf(s * (1.0f / DM) + EPS);
    float4* o = (float4*)(out + (size_t)wave * DM);
    const float4* g4 = (const float4*)g;
#pragma unroll
    for (int j = 0; j < 4; ++j) { const float4 gg = g4[lane + 64 * j]; float4 r; r.x = v[j].x * rs * gg.x; r.y = v[j].y * rs * gg.y; r.z = v[j].z * rs * gg.z; r.w = v[j].w * rs * gg.w; o[lane + 64 * j] = r; }
}

__global__ void __launch_bounds__(256) nk_gemm(const float* __restrict__ A, const float* __restrict__ B, const float* R, float* C, int M, int N, int K) {
    __shared__ float As[16][64 + 4];
    __shared__ float Bs[16][64 + 4];
    const int tid = threadIdx.x, tx = tid & 15, ty = tid >> 4;
    const int m0 = blockIdx.y * 64, n0 = blockIdx.x * 64;
    float acc[4][4];
#pragma unroll
    for (int i = 0; i < 4; ++i)
#pragma unroll
        for (int j = 0; j < 4; ++j) acc[i][j] = 0.f;
    for (int k0 = 0; k0 < K; k0 += 16) {
        {
            const int r = tid >> 2, kk = (tid & 3) * 4;
            const float4 a = *(const float4*)(A + (size_t)(m0 + r) * K + k0 + kk);
            As[kk + 0][r] = a.x; As[kk + 1][r] = a.y; As[kk + 2][r] = a.z; As[kk + 3][r] = a.w;
        }
        {
            const int kk = tid >> 4, c = (tid & 15) * 4;
            const float4 b = *(const float4*)(B + (size_t)(k0 + kk) * N + n0 + c);
            Bs[kk][c + 0] = b.x; Bs[kk][c + 1] = b.y; Bs[kk][c + 2] = b.z; Bs[kk][c + 3] = b.w;
        }
        __syncthreads();
#pragma unroll
        for (int kk = 0; kk < 16; ++kk) {
            float a[4], b[4];
#pragma unroll
            for (int i = 0; i < 4; ++i) a[i] = As[kk][ty * 4 + i];
#pragma unroll
            for (int j = 0; j < 4; ++j) b[j] = Bs[kk][tx * 4 + j];
#pragma unroll
            for (int i = 0; i < 4; ++i)
#pragma unroll
                for (int j = 0; j < 4; ++j) acc[i][j] += a[i] * b[j];
        }
        __syncthreads();
    }
#pragma unroll
    for (int i = 0; i < 4; ++i) {
        const size_t off = (size_t)(m0 + ty * 4 + i) * N + n0 + tx * 4;
        float4 r; r.x = acc[i][0]; r.y = acc[i][1]; r.z = acc[i][2]; r.w = acc[i][3];
        if (R) { const float4 b = *(const float4*)(R + off); r.x += b.x; r.y += b.y; r.z += b.z; r.w += b.w; }
        *(float4*)(C + off) = r;
    }
}

__device__ __forceinline__ void head_info(int hs, int& type, int& gi) {
    if (hs < 6) { type = 1; gi = 0; }
    else if (hs < 8) { type = 1; gi = 1; }
    else if (hs < 10) { type = 0; gi = 0; }
    else if (hs < 16) { type = 2; gi = 2; }
    else if (hs < 22) { type = 2; gi = 3; }
    else if (hs < 28) { type = 0; gi = 0; }
    else if (hs < 32) { type = 2; gi = 4; }
    else if (hs < 34) { type = 2; gi = 5; }
    else { type = 0; gi = 0; }
}
__global__ void __launch_bounds__(256) nk_qknorm_rope(float* __restrict__ P, const float* __restrict__ gain  ) {
    const long w = ((long)blockIdx.x * 256 + threadIdx.x) >> 6; const int lane = threadIdx.x & 63;
    const long tok = w / 36; const int hs = (int)(w % 36);
    if (tok >= MTOK) return;
    int type, gi; head_info(hs, type, gi);
    if (type == 0) return;
    float* p = P + (size_t)tok * PW + hs * 64;
    const float x = p[lane];
    const float ss = wave_sum(x * x);
    const float y = x * rsqrtf(ss * (1.0f / 64.0f) + EPS) * gain[gi * 64 + lane];
    const int pos = (int)(tok % SEQ);
    float outv;
    if (type == 2) {
        const int i = lane & 31;
        const float invf = powf(10000.0f, -(float)i / 32.0f);
        const float ang = (float)pos * invf;
        const float c = cosf(ang), s = sinf(ang);
        const float other = __shfl_xor(y, 32);
        outv = (lane < 32) ? (y * c - other * s) : (other * s + y * c);
    } else {
        const int i = lane & 15;
        const float invf = powf(10000.0f, -(float)i / 16.0f);
        const float pp = (lane < 32) ? (float)(pos / 64) : (float)(pos % 64);
        const float ang = pp * invf;
        const float c = cosf(ang), s = sinf(ang);
        const float other = __shfl_xor(y, 16);
        outv = ((lane & 16) == 0) ? (y * c - other * s) : (other * s + y * c);
    }
    p[lane] = outv;
}

__global__ void __launch_bounds__(256) nk_attn_full(const float* __restrict__ P, float* __restrict__ mix) {
    const int qb = blockIdx.x & 7, h = (blockIdx.x >> 3) % 6, b = blockIdx.x / 48;
    const int qi = qb * 256 + threadIdx.x;
    const int kvh = h / 3;
    const float* qp = P + (size_t)(b * SEQ + qi) * PW + C_QA + h * 64;
    float q[64], o[64];
#pragma unroll
    for (int d = 0; d < 64; ++d) { q[d] = qp[d] * 0.125f; o[d] = 0.f; }
    float m = -1e30f, l = 0.f;
    const float* kbase = P + (size_t)(b * SEQ) * PW + C_KA + kvh * 64;
    const float* vbase = P + (size_t)(b * SEQ) * PW + C_VA + kvh * 64;
    for (int j = 0; j < SEQ; ++j) {
        const float* kr = kbase + (size_t)j * PW;
        const float* vr = vbase + (size_t)j * PW;
        float s = 0.f;
#pragma unroll
        for (int d = 0; d < 64; ++d) s += q[d] * kr[d];
        if (s > m) {
            const float f = __expf(m - s);
            l *= f;
#pragma unroll
            for (int d = 0; d < 64; ++d) o[d] *= f;
            m = s;
        }
        const float p = __expf(s - m);
        l += p;
#pragma unroll
        for (int d = 0; d < 64; ++d) o[d] += p * vr[d];
    }
    const float inv = 1.0f / l;
    float* op = mix + (size_t)(b * SEQ + qi) * DM + h * 64;
#pragma unroll
    for (int d = 0; d < 64; ++d) op[d] = o[d] * inv;
}

template <int MODE>
__global__ void __launch_bounds__(256) nk_attn_band(const float* __restrict__ P, float* __restrict__ mix, const float* __restrict__ sink) {
    constexpr int NH = MODE == 0 ? 6 : 4;
    const int tb = blockIdx.x & 7, h = (blockIdx.x >> 3) % NH, b = blockIdx.x / (8 * NH);
    const int t = tb * 256 + threadIdx.x;
    const int qcol = MODE == 0 ? C_QB + h * 64 : C_QC + h * 64;
    const int kcol = MODE == 0 ? C_KB + h * 64 : C_KC + (h / 2) * 64;
    const int vcol = MODE == 0 ? C_VB + h * 64 : C_VC + (h / 2) * 64;
    const float* qp = P + (size_t)(b * SEQ + t) * PW + qcol;
    float q[64];
#pragma unroll
    for (int d = 0; d < 64; ++d) q[d] = qp[d] * 0.125f;
    float otot[64];
#pragma unroll
    for (int d = 0; d < 64; ++d) otot[d] = 0.f;
    float wtot = 0.f, lse_max = -1e30f;
    constexpr int NBR = MODE == 0 ? 3 : 1;
#pragma unroll 1
    for (int br = 0; br < NBR; ++br) {
        const int r = MODE == 0 ? (br == 0 ? 1 : (br == 1 ? 4 : 16)) : 1;
        const int half = MODE == 0 ? 64 : 128;
        const int L = SEQ / r, i = t / r, c = t % r;
        const int jlo = max(0, i - half), jhi = min(L - 1, i + half);
        float o[64];
#pragma unroll
        for (int d = 0; d < 64; ++d) o[d] = 0.f;
        float m = -1e30f, l = 0.f;
        if (MODE == 1) { m = sink[h]; l = 1.0f; }
        for (int j = jlo; j <= jhi; ++j) {
            const size_t row = (size_t)(b * SEQ + j * r + c) * PW;
            const float* kr = P + row + kcol;
            const float* vr = P + row + vcol;
            float s = 0.f;
#pragma unroll
            for (int d = 0; d < 64; ++d) s += q[d] * kr[d];
            if (s > m) {
                const float f = __expf(m - s);
                l *= f;
#pragma unroll
                for (int d = 0; d < 64; ++d) o[d] *= f;
                m = s;
            }
            const float p = __expf(s - m);
            l += p;
#pragma unroll
            for (int d = 0; d < 64; ++d) o[d] += p * vr[d];
        }
        const float inv = 1.0f / l;
        if (MODE == 1) {
#pragma unroll
            for (int d = 0; d < 64; ++d) otot[d] = o[d] * inv;
            wtot = 1.0f;
        } else {
            const float lse = m + __logf(l);
            if (lse > lse_max) {
                const float f = __expf(lse_max - lse);
                wtot *= f;
#pragma unroll
                for (int d = 0; d < 64; ++d) otot[d] *= f;
                lse_max = lse;
            }
            const float wgt = __expf(lse - lse_max);
            wtot += wgt;
#pragma unroll
            for (int d = 0; d < 64; ++d) otot[d] += wgt * o[d] * inv;
        }
    }
    const float invw = 1.0f / wtot;
    float* op = mix + (size_t)(b * SEQ + t) * DM + (MODE == 0 ? 384 : 768) + h * 64;
#pragma unroll
    for (int d = 0; d < 64; ++d) op[d] = otot[d] * invw;
}

__global__ void __launch_bounds__(256) nk_mixnorm(float* __restrict__ mix, const float* __restrict__ g) {
    const int tok = (blockIdx.x * 256 + threadIdx.x) >> 6, lane = threadIdx.x & 63;
    if (tok >= MTOK) return;
    float* p = mix + (size_t)tok * DM;
    float a[6], bb[6], c[4];
    float sa = 0.f, sb = 0.f, sc = 0.f;
#pragma unroll
    for (int j = 0; j < 6; ++j) { a[j] = p[lane + 64 * j]; sa += a[j] * a[j]; }
#pragma unroll
    for (int j = 0; j < 6; ++j) { bb[j] = p[384 + lane + 64 * j]; sb += bb[j] * bb[j]; }
#pragma unroll
    for (int j = 0; j < 4; ++j) { c[j] = p[768 + lane + 64 * j]; sc += c[j] * c[j]; }
    sa = wave_sum(sa); sb = wave_sum(sb); sc = wave_sum(sc);
    const float ra = rsqrtf(sa * (1.0f / 384.0f) + EPS), rb = rsqrtf(sb * (1.0f / 384.0f) + EPS), rc = rsqrtf(sc * (1.0f / 256.0f) + EPS);
#pragma unroll
    for (int j = 0; j < 6; ++j) p[lane + 64 * j] = a[j] * ra * g[lane + 64 * j];
#pragma unroll
    for (int j = 0; j < 6; ++j) p[384 + lane + 64 * j] = bb[j] * rb * g[384 + lane + 64 * j];
#pragma unroll
    for (int j = 0; j < 4; ++j) p[768 + lane + 64 * j] = c[j] * rc * g[768 + lane + 64 * j];
}

__global__ void __launch_bounds__(256) nk_scores(const float* __restrict__ q, const float* __restrict__ keys, float* __restrict__ S, int p) {
    const long gid = (long)blockIdx.x * 256 + threadIdx.x;
    const int n = (int)(gid & 127), h = (int)((gid >> 7) & 7); const long tok = gid >> 10;
    const float* qp = q + (size_t)tok * DM + h * 128 + p * 64;
    const float* kp = keys + ((size_t)(h * 2 + p) * NKEYS + n) * 64;
    float s = 0.f;
#pragma unroll
    for (int d = 0; d < 64; ++d) s += qp[d] * kp[d];
    S[gid] = s;
}
__global__ void __launch_bounds__(256) nk_topk(const float* __restrict__ S, float* __restrict__ sv, int* __restrict__ si, int p) {
    const long gid = (long)blockIdx.x * 256 + threadIdx.x;
    const float* s = S + gid * 128;
    float pv = INFINITY; int pi = -1;
    for (int k = 0; k < TOPK; ++k) {
        float bv = -INFINITY; int bi = 1 << 30;
        for (int n = 0; n < 128; ++n) {
            const float v = s[n];
            const bool elig = (v < pv) || (v == pv && n > pi);
            if (elig && (v > bv || (v == bv && n < bi))) { bv = v; bi = n; }
        }
        sv[(gid * 2 + p) * 16 + k] = bv; si[(gid * 2 + p) * 16 + k] = bi;
        pv = bv; pi = bi;
    }
}
__global__ void __launch_bounds__(256) nk_cand(const float* __restrict__ sv, const int* __restrict__ si, int* __restrict__ idx, float* __restrict__ gate) {
    const long gid = (long)blockIdx.x * 256 + threadIdx.x;
    const float* v0 = sv + gid * 32; const float* v1 = v0 + 16;
    const int* i0 = si + gid * 32; const int* i1 = i0 + 16;
    float pv = INFINITY; int pi = -1;
    float best0 = 0.f, denom = 0.f;
    for (int k = 0; k < TOPK; ++k) {
        float bv = -INFINITY; int bi = 1 << 30;
        for (int c = 0; c < 256; ++c) {
            const float v = v0[c >> 4] + v1[c & 15];
            const bool elig = (v < pv) || (v == pv && c > pi);
            if (elig && (v > bv || (v == bv && c < bi))) { bv = v; bi = c; }
        }
        if (k == 0) best0 = bv;
        const float e = __expf(bv - best0);
        denom += e;
        idx[gid * 16 + k] = i0[bi >> 4] * NKEYS + i1[bi & 15];
        gate[gid * 16 + k] = e;
        pv = bv; pi = bi;
    }
    const float inv = 1.0f / denom;
    for (int k = 0; k < TOPK; ++k) gate[gid * 16 + k] *= inv;
}
__global__ void __launch_bounds__(256) nk_act(const float* __restrict__ h2, const float* __restrict__ u, const int* __restrict__ idx, float* __restrict__ gate_act) {
    const long w = ((long)blockIdx.x * 256 + threadIdx.x) >> 6; const int lane = threadIdx.x & 63;
    const long tok = w >> 7;
    const int e = idx[w];
    const float4* xr = (const float4*)(h2 + (size_t)tok * DM);
    const float4* ur = (const float4*)(u + (size_t)e * DM);
    float s = 0.f;
#pragma unroll
    for (int j = 0; j < 4; ++j) { const float4 a = xr[lane + 64 * j], b = ur[lane + 64 * j]; s += a.x * b.x + a.y * b.y + a.z * b.z + a.w * b.w; }
    s = wave_sum(s);
    if (lane == 0) { const float g = 0.5f * s * (1.0f + erff(s * 0.70710678118654752f)); gate_act[w] = g * gate_act[w]; }
}
__global__ void __launch_bounds__(256) nk_out(float* __restrict__ x, const float* __restrict__ v, const int* __restrict__ idx, const float* __restrict__ act) {
    const long tok = blockIdx.x; const int t = threadIdx.x;
    float4 acc = *(const float4*)(x + (size_t)tok * DM + t * 4);
    for (int s = 0; s < 128; ++s) {
        const int e = idx[tok * 128 + s]; const float a = act[tok * 128 + s];
        const float4 vv = *(const float4*)(v + (size_t)e * DM + t * 4);
        acc.x += a * vv.x; acc.y += a * vv.y; acc.z += a * vv.z; acc.w += a * vv.w;
    }
    *(float4*)(x + (size_t)tok * DM + t * 4) = acc;
}

extern "C" void kernel_launch(void* const* d_in, const int* in_sizes, int n_in, void* d_out, int out_size, void* d_ws, size_t ws_size, hipStream_t stream) {
    const float* x = (const float*)d_in[0];
    const float* attn_norm = (const float*)d_in[1];
    const float* w_in = (const float*)d_in[2];
    const float* qk_gain = (const float*)d_in[3];
    const float* sink = (const float*)d_in[4];
    const float* out_norm = (const float*)d_in[5];
    const float* w_out = (const float*)d_in[6];
    const float* ffn_norm = (const float*)d_in[7];
    const float* peer_wq = (const float*)d_in[8];
    const float* peer_keys = (const float*)d_in[9];
    const float* peer_u = (const float*)d_in[10];
    const float* peer_v = (const float*)d_in[11];
    float* out = (float*)d_out;
    char* ws = (char*)d_ws;
    const size_t MiB = 1u << 20;
    if (ws_size < 500 * MiB) { fprintf(stderr, "workspace too small: %zu\n", ws_size); return; }
    float* RA = (float*)(ws + 0);
    float* RP = (float*)(ws + 128 * MiB);
    float* Q = RP;
    float* S = (float*)(ws + 256 * MiB);
    float* SV = (float*)(ws + 384 * MiB);
    int* IDX = (int*)(ws + 420 * MiB);
    float* GATE = (float*)(ws + 440 * MiB);
    int* SI = (int*)(ws + 460 * MiB);
    for (int l = 0; l < DEPTH; ++l) {
        const float* xin = (l == 0) ? x : out;
        nk_rmsnorm<<<MTOK / 4, 256, 0, stream>>>(xin, attn_norm + l * DM, RA, MTOK);
        nk_gemm<<<dim3(PW / 64, MTOK / 64), 256, 0, stream>>>(RA, w_in + (size_t)l * DM * PW, nullptr, RP, MTOK, PW, DM);
        nk_qknorm_rope<<<(unsigned)(((long)MTOK * 36 * 64) / 256), 256, 0, stream>>>(RP, qk_gain + l * 384);
        nk_attn_full<<<BATCH * 6 * 8, 256, 0, stream>>>(RP, RA);
        nk_attn_band<0><<<BATCH * 6 * 8, 256, 0, stream>>>(RP, RA, nullptr);
        nk_attn_band<1><<<BATCH * 4 * 8, 256, 0, stream>>>(RP, RA, sink + l * 4);
        nk_mixnorm<<<MTOK / 4, 256, 0, stream>>>(RA, out_norm + l * DM);
        nk_gemm<<<dim3(DM / 64, MTOK / 64), 256, 0, stream>>>(RA, w_out + (size_t)l * DM * DM, xin, out, MTOK, DM, DM);
        nk_rmsnorm<<<MTOK / 4, 256, 0, stream>>>(out, ffn_norm + l * DM, RA, MTOK);
        nk_gemm<<<dim3(DM / 64, MTOK / 64), 256, 0, stream>>>(RA, peer_wq + (size_t)l * DM * DM, nullptr, Q, MTOK, DM, DM);
        for (int p = 0; p < 2; ++p) {
            nk_scores<<<(unsigned)(((long)MTOK * 8 * 128) / 256), 256, 0, stream>>>(Q, peer_keys + (size_t)l * 8 * 2 * 128 * 64, S, p);
            nk_topk<<<MTOK * 8 / 256, 256, 0, stream>>>(S, SV, SI, p);
        }
        nk_cand<<<MTOK * 8 / 256, 256, 0, stream>>>(SV, SI, IDX, GATE);
        nk_act<<<(unsigned)(((long)MTOK * 128 * 64) / 256), 256, 0, stream>>>(RA, peer_u + (size_t)l * NEXP * DM, IDX, GATE);
        nk_out<<<MTOK, 256, 0, stream>>>(out, peer_v + (size_t)l * NEXP * DM, IDX, GATE);
    }
}
```

```cpp
#include <hip/hip_runtime.h>
#include <hip/hip_cooperative_groups.h>
#include <cstdio>
#include <cstdint>
#include <cmath>
namespace cg = cooperative_groups;

constexpr int BATCH = 16, SEQ = 2048, DM = 1024, DEPTH = 2;
constexpr int MTOK = BATCH * SEQ;
constexpr int PW = 2304;
constexpr int NKEYS = 128, NEXP = NKEYS * NKEYS;
constexpr float EPS = 1e-6f;
constexpr int C_QA = 0, C_KA = 384, C_VA = 512, C_QB = 640, C_KB = 1024, C_VB = 1408, C_QC = 1792, C_KC = 2048, C_VC = 2176;
constexpr float LOG2E = 1.4426950408889634f;
constexpr float QSCALE = 0.125f * LOG2E;

#define LAS __attribute__((address_space(3)))
typedef unsigned short bf16_t;
typedef short bf16x8 __attribute__((ext_vector_type(8)));
typedef short s16x4 __attribute__((ext_vector_type(4)));
typedef float f32x4 __attribute__((ext_vector_type(4)));
typedef float f32x16 __attribute__((ext_vector_type(16)));
typedef unsigned u32x4 __attribute__((ext_vector_type(4)));
typedef unsigned u32x2 __attribute__((ext_vector_type(2)));
typedef float f32x2_t __attribute__((ext_vector_type(2)));
typedef __bf16 bf16x2_t __attribute__((ext_vector_type(2)));

__device__ __forceinline__ unsigned cvtpk(float lo, float hi) { f32x2_t v = {lo, hi}; bf16x2_t b = __builtin_convertvector(v, bf16x2_t); return __builtin_bit_cast(unsigned, b); }
__device__ __forceinline__ float bf_lo(unsigned w) { return __uint_as_float(w << 16); }
__device__ __forceinline__ float bf_hi(unsigned w) { return __uint_as_float(w & 0xffff0000u); }
__device__ __forceinline__ float wave_sum(float v) {
#pragma unroll
    for (int o = 1; o < 64; o <<= 1) v += __shfl_xor(v, o);
    return v;
}

constexpr size_t MiB = 1u << 20;
constexpr size_t WS_CTL = 0, CTL_BYTES = 1 * MiB;
constexpr size_t WS_WIN = 1 * MiB;
constexpr size_t WS_WOUT = 10 * MiB;
constexpr size_t WS_WQ = 14 * MiB;
constexpr size_t WS_KEYS = 18 * MiB;
constexpr size_t WS_LSE = 19 * MiB;
constexpr size_t WS_ROPE = 22 * MiB;
constexpr size_t WS_U = 24 * MiB;
constexpr size_t WS_V = 88 * MiB;
constexpr size_t WS_H = 152 * MiB;
constexpr size_t WS_P = 216 * MiB;
constexpr size_t WS_MIX = 360 * MiB;
constexpr size_t WS_OB = 424 * MiB;
constexpr size_t WS_END = 496 * MiB;
constexpr size_t WS_Q = WS_P;
constexpr size_t WS_IDX = WS_P + 64 * MiB;
constexpr size_t WS_GATE = WS_P + 72 * MiB;

constexpr int NWAVES = 8, NTHREADS = 512;
constexpr int LDS_BYTES = 147456;

namespace pg8 {
#define PG8_LAS __attribute__((address_space(3)))
typedef unsigned short bf16_t;
typedef short bf16x8 __attribute__((ext_vector_type(8)));
typedef float f32x4 __attribute__((ext_vector_type(4)));
typedef unsigned u32x4 __attribute__((ext_vector_type(4)));
constexpr int BM = 256, BK = 64, HALF = 128, HTB = HALF * BK * 2  , STAGE_BYTES = 8 * HTB, NXCD = 8, WGM = 8;

__host__ __device__ __forceinline__ int lds_byte(int r, int c) { const int st = (r >> 4) * 2 + (c >> 5), rr = r & 15, cc = c & 31, ob = rr * 64 + cc * 2; return st * 1024 + (ob ^ (((ob >> 9) & 1) << 5)); }
__host__ __device__ __forceinline__ void stage_rc(int b, int& R, int& C) { const int st = b / 1024, sb = b % 1024, swz = sb ^ (((sb >> 9) & 1) << 5); R = (st >> 1) * 16 + swz / 64; C = (st & 1) * 32 + (swz % 64) / 2; }
__host__ __device__ __forceinline__ int perm32(int rho) { const int n = rho >> 4, i = rho & 15; return 8 * (i >> 2) + 4 * n + (i & 3); }

struct Unit { int pm, pn; };
struct Gemm { const bf16_t* A; const bf16_t* Bt; int M, N, K; };

struct StaticOrder {
    int nM, nN, nwg, G, c;
    __host__ __device__ void init(int M, int N, int G_, int c_) { nM = M / BM; nN = N / BM; nwg = nM * nN; G = G_; c = c_; }
    __host__ __device__ bool next(int i, Unit& u) const {
        const long L = (long)i * G + c; if (L >= nwg) return false;
        int wgid = (int)L; { const int q = nwg / NXCD, r = nwg % NXCD, xcd = wgid % NXCD, off = wgid / NXCD; wgid = (xcd < r ? xcd * (q + 1) : r * (q + 1) + (xcd - r) * q) + off; }
        const int nig = WGM * nN, gid = wgid / nig, fm = gid * WGM, gsz = (nM - fm) < WGM ? (nM - fm) : WGM;
        u.pm = fm + ((wgid % nig) % gsz); u.pn = (wgid % nig) / gsz; return true;
    }
    __device__ __forceinline__ void a_ready(const Unit&) const {}
    __device__ __forceinline__ void done(const Unit&) const {}
};


struct EpiBf16 {
    static constexpr bool PERM = true, AFTER_DRAIN = false;
    bf16_t* O; int ldc;
    __device__ __forceinline__ void operator()(const f32x4 (&acc)[2][2][4][2], const Unit& u, int wr, int wc, int fr, int fq) const {
        const int row0 = u.pm * BM + wr * 64 + fr; const int col0 = u.pn * BM + wc * 32 + 8 * fq;
#pragma unroll
        for (int ai = 0; ai < 2; ++ai)
#pragma unroll
            for (int m = 0; m < 4; ++m) { bf16_t* rowp = O + (size_t)(row0 + ai * HALF + m * 16) * ldc + col0;
#pragma unroll
                for (int bj = 0; bj < 2; ++bj) { const f32x4 v0 = acc[ai][bj][m][0], v1 = acc[ai][bj][m][1];
                    u32x4 w; w.x = ::cvtpk(v0[0], v0[1]); w.y = ::cvtpk(v0[2], v0[3]); w.z = ::cvtpk(v1[0], v1[1]); w.w = ::cvtpk(v1[2], v1[3]);
                    *(u32x4*)(rowp + bj * HALF) = w; } }
    }
};
struct EpiResF32 {
    static constexpr bool PERM = false, AFTER_DRAIN = false;
    const float* base; float* C; int ldc;
    __device__ __forceinline__ void operator()(const f32x4 (&acc)[2][2][4][2], const Unit& u, int wr, int wc, int fr, int fq) const {
        const int row0 = u.pm * BM + wr * 64 + fr, col0 = u.pn * BM + wc * 32 + 4 * fq;
#pragma unroll
        for (int ai = 0; ai < 2; ++ai)
#pragma unroll
            for (int m = 0; m < 4; ++m) { const size_t off = (size_t)(row0 + ai * HALF + m * 16) * ldc + col0;
#pragma unroll
                for (int bj = 0; bj < 2; ++bj)
#pragma unroll
                    for (int n = 0; n < 2; ++n) { const f32x4 b = *(const f32x4*)(base + off + bj * HALF + n * 16); *(f32x4*)(C + off + bj * HALF + n * 16) = acc[ai][bj][m][n] + b; } }
    }
};

template <class Epi, class Sched, bool ALIGN_EPI = false, bool SP2 = false>
__device__ __forceinline__ void gemm_phase(PG8_LAS unsigned char* lds, const Gemm g, const Sched& S, const Epi& E) {
    int tid_l = threadIdx.x; asm volatile("" : "+v"(tid_l));
    const int tid = tid_l, wid = __builtin_amdgcn_readfirstlane(tid >> 6), lane = tid & 63, wr = wid >> 2, wc = wid & 3, fr = lane & 15, fq = lane >> 4;
    const int K = g.K, nt = K / BK;
    unsigned voffA[2], voffB[2];
#pragma unroll
    for (int i = 0; i < 2; ++i) { int R, C; stage_rc(tid * 16 + i * 8192, R, C); const int Rb = Epi::PERM ? ((R & ~31) + perm32(R & 31)) : R;
        voffA[i] = (unsigned)(R * K + C) * 2u; voffB[i] = (unsigned)(Rb * K + C) * 2u; }
    const size_t kstep = (size_t)(BK * 2);
    const size_t hstep = (size_t)HALF * K * 2;
    const size_t tstep = 2 * hstep;
    const unsigned ldsw = (unsigned)wid * 1024u;
    const int aoff = lds_byte(wr * 64 + fr, fq * 8), boff = lds_byte(wc * 32 + fr, fq * 8);
#define PG8_SA(b, h) (((b) * 2 + (h)) * HTB)
#define PG8_SB(b, h) ((4 + (b) * 2 + (h)) * HTB)
#define PG8_STAGE(bufoff, gbase, voff) do { _Pragma("unroll") for (int _i = 0; _i < 2; ++_i) \
        __builtin_amdgcn_global_load_lds((const unsigned*)((const char*)(gbase) + (voff)[_i]), (PG8_LAS unsigned*)(lds + (bufoff) + ldsw + _i * 8192), 16, 0, 0); } while (0)
#define PG8_LDA(dst, b, h) do { _Pragma("unroll") for (int m = 0; m < 4; ++m) _Pragma("unroll") for (int k = 0; k < 2; ++k) dst[m][k] = *(const PG8_LAS bf16x8*)(lds + PG8_SA(b, h) + aoff + m * 2048 + k * 1024); } while (0)
#define PG8_LDB(dst, b, h) do { _Pragma("unroll") for (int n = 0; n < 2; ++n) _Pragma("unroll") for (int k = 0; k < 2; ++k) dst[n][k] = *(const PG8_LAS bf16x8*)(lds + PG8_SB(b, h) + boff + n * 2048 + k * 1024); } while (0)
#define PG8_MMA(ai, bj, At, Bt) do { __builtin_amdgcn_s_setprio(1); _Pragma("unroll") for (int m = 0; m < 4; ++m) _Pragma("unroll") for (int n = 0; n < 2; ++n) _Pragma("unroll") for (int k = 0; k < 2; ++k) \
        acc[ai][bj][m][n] = __builtin_amdgcn_mfma_f32_16x16x32_bf16(Bt[n][k], At[m][k], acc[ai][bj][m][n], 0, 0, 0); __builtin_amdgcn_s_setprio(0); } while (0)
#define PG8_WAIT_V(n) asm volatile("s_waitcnt vmcnt(" #n ")" ::: "memory")
#define PG8_WAIT_L(n) asm volatile("s_waitcnt lgkmcnt(" #n ")" ::: "memory")
#define PG8_BAR __builtin_amdgcn_s_barrier()
#define PG8_SCHED __builtin_amdgcn_sched_barrier(0)
    Unit cur, nxt; int ui = 0;
    if (!S.next(0, cur)) return;
    f32x4 acc[2][2][4][2];
#pragma unroll
    for (int a = 0; a < 2; ++a)
#pragma unroll
        for (int b = 0; b < 2; ++b)
#pragma unroll
            for (int m = 0; m < 4; ++m)
#pragma unroll
                for (int n = 0; n < 2; ++n) acc[a][b][m][n] = (f32x4){0.f, 0.f, 0.f, 0.f};
    bf16x8 At[4][2], B0[2][2], B1[2][2];
    const char* cA = (const char*)g.A + (size_t)cur.pm * tstep; const char* cB = (const char*)g.Bt + (size_t)cur.pn * tstep;
    S.a_ready(cur);
    if constexpr (SP2) {
        PG8_STAGE(PG8_SB(0, 0), cB, voffB); PG8_STAGE(PG8_SB(0, 1), cB + hstep, voffB); PG8_STAGE(PG8_SA(0, 0), cA, voffA); PG8_STAGE(PG8_SA(0, 1), cA + hstep, voffA);
        if (wr == 1) PG8_BAR;
        PG8_WAIT_V(2); PG8_BAR;
        PG8_STAGE(PG8_SB(1, 0), cB + kstep, voffB); PG8_STAGE(PG8_SA(1, 0), cA + kstep, voffA); PG8_STAGE(PG8_SB(1, 1), cB + hstep + kstep, voffB);
        PG8_WAIT_V(6); PG8_BAR;
    } else {
        PG8_STAGE(PG8_SB(0, 0), cB, voffB); PG8_STAGE(PG8_SA(0, 0), cA, voffA); PG8_STAGE(PG8_SB(0, 1), cB + hstep, voffB); PG8_STAGE(PG8_SA(0, 1), cA + hstep, voffA);
        if (wr == 1) PG8_BAR;
        PG8_WAIT_V(4); PG8_BAR;
        PG8_STAGE(PG8_SB(1, 0), cB + kstep, voffB); PG8_STAGE(PG8_SA(1, 0), cA + kstep, voffA); PG8_STAGE(PG8_SB(1, 1), cB + hstep + kstep, voffB);
        PG8_WAIT_V(6); PG8_BAR;
    }
    for (;;) {
        const bool has_next = S.next(ui + 1, nxt);
        const char* nA = has_next ? (const char*)g.A + (size_t)nxt.pm * tstep : cA; const char* nB = has_next ? (const char*)g.Bt + (size_t)nxt.pn * tstep : cB;
        for (int t = 0; t < nt; t += 2) {
            const bool last = (t == nt - 2);
            const char* a1 = cA + (size_t)(t + 1) * kstep;
            const char* a2 = last ? nA : cA + (size_t)(t + 2) * kstep; const char* b2 = last ? nB : cB + (size_t)(t + 2) * kstep;
            const char* a3 = a2 + kstep; const char* b3 = b2 + kstep;
            if (last && has_next) S.a_ready(nxt);
            if constexpr (SP2) {
            PG8_LDB(B0, 0, 0); PG8_LDB(B1, 0, 1); PG8_SCHED; PG8_LDA(At, 0, 0); PG8_STAGE(PG8_SA(1, 1), a1 + hstep, voffA);
            PG8_WAIT_V(8); PG8_WAIT_L(0); PG8_BAR; PG8_MMA(0, 0, At, B0); PG8_MMA(0, 1, At, B1); PG8_BAR; PG8_SCHED;
            PG8_LDA(At, 0, 1); PG8_STAGE(PG8_SB(0, 0), b2, voffB); PG8_STAGE(PG8_SB(0, 1), b2 + hstep, voffB); PG8_STAGE(PG8_SA(0, 0), a2, voffA);
            PG8_WAIT_V(8); PG8_WAIT_L(0); PG8_BAR; PG8_MMA(1, 0, At, B0); PG8_MMA(1, 1, At, B1); PG8_BAR; PG8_SCHED;
            PG8_LDB(B0, 1, 0); PG8_LDB(B1, 1, 1); PG8_SCHED; PG8_LDA(At, 1, 0); PG8_STAGE(PG8_SA(0, 1), a2 + hstep, voffA);
            PG8_WAIT_V(8); PG8_WAIT_L(0); PG8_BAR; PG8_MMA(0, 0, At, B0); PG8_MMA(0, 1, At, B1); PG8_BAR; PG8_SCHED;
            PG8_LDA(At, 1, 1); PG8_STAGE(PG8_SB(1, 0), b3, voffB); PG8_STAGE(PG8_SB(1, 1), b3 + hstep, voffB); PG8_STAGE(PG8_SA(1, 0), a3, voffA);
            PG8_WAIT_V(8); PG8_WAIT_L(0); PG8_BAR; PG8_MMA(1, 0, At, B0); PG8_MMA(1, 1, At, B1); PG8_BAR; PG8_SCHED;
            } else {
            PG8_LDB(B0, 0, 0); PG8_SCHED; PG8_LDA(At, 0, 0); PG8_STAGE(PG8_SA(1, 1), a1 + hstep, voffA);
            PG8_WAIT_L(8); PG8_BAR; PG8_WAIT_L(0); PG8_MMA(0, 0, At, B0); PG8_BAR; PG8_SCHED;
            PG8_LDB(B1, 0, 1); PG8_STAGE(PG8_SB(0, 0), b2, voffB);
            PG8_BAR; PG8_WAIT_L(0); PG8_MMA(0, 1, At, B1); PG8_BAR;
            PG8_LDA(At, 0, 1); PG8_STAGE(PG8_SA(0, 0), a2, voffA);
            PG8_BAR; PG8_WAIT_L(0); PG8_MMA(1, 0, At, B0); PG8_BAR; PG8_SCHED;
            PG8_STAGE(PG8_SB(0, 1), b2 + hstep, voffB);
            PG8_WAIT_V(6); PG8_BAR; PG8_MMA(1, 1, At, B1); PG8_BAR;
            PG8_LDB(B0, 1, 0); PG8_SCHED; PG8_LDA(At, 1, 0); PG8_STAGE(PG8_SA(0, 1), a2 + hstep, voffA);
            PG8_WAIT_L(8); PG8_BAR; PG8_WAIT_L(0); PG8_MMA(0, 0, At, B0); PG8_BAR; PG8_SCHED;
            PG8_LDB(B1, 1, 1); PG8_STAGE(PG8_SB(1, 0), b3, voffB);
            PG8_BAR; PG8_WAIT_L(0); PG8_MMA(0, 1, At, B1); PG8_BAR;
            PG8_LDA(At, 1, 1); PG8_STAGE(PG8_SA(1, 0), a3, voffA);
            PG8_BAR; PG8_WAIT_L(0); PG8_MMA(1, 0, At, B0); PG8_BAR; PG8_SCHED;
            PG8_STAGE(PG8_SB(1, 1), b3 + hstep, voffB);
            PG8_WAIT_V(6); PG8_BAR; PG8_MMA(1, 1, At, B1); PG8_BAR;
            }
        }
        if constexpr (ALIGN_EPI) { if (wr == 0) PG8_BAR; }
        if constexpr (!Epi::AFTER_DRAIN) { E(acc, cur, wr, wc, fr, fq); S.done(cur); }
        if (!has_next) break;
#pragma unroll
        for (int a = 0; a < 2; ++a)
#pragma unroll
            for (int b = 0; b < 2; ++b)
#pragma unroll
                for (int m = 0; m < 4; ++m)
#pragma unroll
                    for (int n = 0; n < 2; ++n) acc[a][b][m][n] = (f32x4){0.f, 0.f, 0.f, 0.f};
        cur = nxt; cA = nA; cB = nB; ++ui;
        if constexpr (ALIGN_EPI) { if (wr == 1) PG8_BAR; }
    }
    PG8_WAIT_V(0);
    if constexpr (!ALIGN_EPI) { if (wr == 0) PG8_BAR; }
    PG8_BAR;
    if constexpr (Epi::AFTER_DRAIN) { E.fused(acc, cur, wr, wc, fr, fq, lds, wid, lane); S.done(cur); }
#undef PG8_SA
#undef PG8_SB
#undef PG8_STAGE
#undef PG8_LDA
#undef PG8_LDB
#undef PG8_MMA
#undef PG8_WAIT_V
#undef PG8_WAIT_L
#undef PG8_BAR
#undef PG8_SCHED
}
}

__device__ __forceinline__ int crow(int r, int hi) { return (r & 3) + 8 * (r >> 2) + 4 * hi; }
__device__ __forceinline__ float fmax3(float a, float b, float c) { return fmaxf(fmaxf(a, b), c); }

__device__ __forceinline__ void norm_row_to_bf16(const float* xrow, const float* g, bf16_t* orow, int lane) {
    const f32x4* xr = (const f32x4*)xrow + lane;
    const f32x4* gr = (const f32x4*)g + lane;
    f32x4 v[4]; float s = 0.f;
#pragma unroll
    for (int j = 0; j < 4; ++j) { v[j] = xr[64 * j]; s += (v[j].x * v[j].x + v[j].y * v[j].y) + (v[j].z * v[j].z + v[j].w * v[j].w); }
    const float rs = rsqrtf(wave_sum(s) * (1.0f / DM) + EPS);
    u32x2* o8 = (u32x2*)orow + lane;
#pragma unroll
    for (int j = 0; j < 4; ++j) { const f32x4 gg = gr[64 * j]; u32x2 w; w.x = cvtpk(v[j].x * rs * gg.x, v[j].y * rs * gg.y); w.y = cvtpk(v[j].z * rs * gg.z, v[j].w * rs * gg.w); o8[64 * j] = w; }
}

__device__ __forceinline__ void p0_transpose_item(const float* W, int K, int N, bf16_t* WT, LAS float* scr, int item, int lane) {
    const int nblk = N / 32, kb = item / nblk, nb = item % nblk, k0 = 64 * kb, n0 = 32 * nb;
#pragma unroll 8
    for (int i = 0; i < 32; ++i) { const int kk = 2 * i + (lane >> 5); scr[kk * 33 + (lane & 31)] = W[(size_t)(k0 + kk) * N + n0 + (lane & 31)]; }
    asm volatile("s_waitcnt lgkmcnt(0)" ::: "memory");
    const int c = lane & 7;
#pragma unroll
    for (int j = 0; j < 4; ++j) { const int n = (lane >> 3) + 8 * j; const LAS float* s = scr + (8 * c) * 33 + n;
        u32x4 o; o.x = cvtpk(s[0 * 33], s[1 * 33]); o.y = cvtpk(s[2 * 33], s[3 * 33]); o.z = cvtpk(s[4 * 33], s[5 * 33]); o.w = cvtpk(s[6 * 33], s[7 * 33]);
        *(u32x4*)(WT + (size_t)(n0 + n) * K + k0 + 8 * c) = o; }
    asm volatile("s_waitcnt lgkmcnt(0)" ::: "memory");
}

struct Ctx {
    LAS unsigned char* lds;
    int tid, lane, wave, vcu, G, gw, NGW;
    const float* const* in; float* out; unsigned char* ws;
};

__device__ __forceinline__ void phase_p0(const Ctx& F) {
    const float* w_in = F.in[2]; const float* w_out = F.in[6]; const float* wq = F.in[8]; const float* keys = F.in[9];
    const float* pu = F.in[10]; const float* pv = F.in[11];
    LAS float* scr = (LAS float*)(F.lds + F.wave * 16384);
    constexpr int I_IN = 16 * 72, I_SQ = 16 * 32, I_L = I_IN + 2 * I_SQ, NIT = 2 * I_L;
    for (int it = F.gw; it < NIT; it += F.NGW) {
        const int l = it / I_L, r = it % I_L;
        if (r < I_IN) p0_transpose_item(w_in + (size_t)l * DM * PW, DM, PW, (bf16_t*)(F.ws + WS_WIN) + (size_t)l * PW * DM, scr, r, F.lane);
        else if (r < I_IN + I_SQ) p0_transpose_item(w_out + (size_t)l * DM * DM, DM, DM, (bf16_t*)(F.ws + WS_WOUT) + (size_t)l * DM * DM, scr, r - I_IN, F.lane);
        else p0_transpose_item(wq + (size_t)l * DM * DM, DM, DM, (bf16_t*)(F.ws + WS_WQ) + (size_t)l * DM * DM, scr, r - I_IN - I_SQ, F.lane);
    }
    const int gtid = F.vcu * NTHREADS + F.tid, NT = F.G * NTHREADS;
    for (int i = gtid; i < 262144 / 8; i += NT) {
        const f32x4 a = *(const f32x4*)(keys + (size_t)i * 8), b = *(const f32x4*)(keys + (size_t)i * 8 + 4);
        u32x4 o; o.x = cvtpk(a.x, a.y); o.y = cvtpk(a.z, a.w); o.z = cvtpk(b.x, b.y); o.w = cvtpk(b.z, b.w);
        *(u32x4*)((bf16_t*)(F.ws + WS_KEYS) + (size_t)i * 8) = o;
    }
    for (int i = gtid; i < (1 << 22); i += NT) {
        { const f32x4 a = *(const f32x4*)(pu + (size_t)i * 8), b = *(const f32x4*)(pu + (size_t)i * 8 + 4);
          u32x4 o; o.x = cvtpk(a.x, a.y); o.y = cvtpk(a.z, a.w); o.z = cvtpk(b.x, b.y); o.w = cvtpk(b.z, b.w);
          *(u32x4*)((bf16_t*)(F.ws + WS_U) + (size_t)i * 8) = o; }
        { const f32x4 a = *(const f32x4*)(pv + (size_t)i * 8), b = *(const f32x4*)(pv + (size_t)i * 8 + 4);
          u32x4 o; o.x = cvtpk(a.x, a.y); o.y = cvtpk(a.z, a.w); o.z = cvtpk(b.x, b.y); o.w = cvtpk(b.z, b.w);
          *(u32x4*)((bf16_t*)(F.ws + WS_V) + (size_t)i * 8) = o; }
    }
    for (int e = gtid; e < 2048 * 64; e += NT) {
        const int pos = e >> 6, i = e & 63;
        float ang;
        if (i < 32) ang = (float)pos * powf(10000.0f, -(float)i / 32.0f);
        else if (i < 48) ang = (float)(pos >> 6) * powf(10000.0f, -(float)(i - 32) / 16.0f);
        else ang = (float)(pos & 63) * powf(10000.0f, -(float)(i - 48) / 16.0f);
        f32x2_t cs; cs.x = cosf(ang); cs.y = sinf(ang);
        ((f32x2_t*)(F.ws + WS_ROPE))[e] = cs;
    }
    for (int m = F.gw; m < MTOK; m += F.NGW) norm_row_to_bf16(F.in[0] + (size_t)m * DM, F.in[1], (bf16_t*)(F.ws + WS_H) + (size_t)m * DM, F.lane);
}

__device__ __forceinline__ void phase_norm(const Ctx& F, const float* x, const float* g) {
    for (int m = F.gw; m < MTOK; m += F.NGW) norm_row_to_bf16(x + (size_t)m * DM, g, (bf16_t*)(F.ws + WS_H) + (size_t)m * DM, F.lane);
}

__device__ __forceinline__ void head_info(int hs, int& type, int& gi) {
    if (hs < 6) { type = 1; gi = 0; } else if (hs < 8) { type = 1; gi = 1; } else if (hs < 10) { type = 0; gi = 0; }
    else if (hs < 16) { type = 2; gi = 2; } else if (hs < 22) { type = 2; gi = 3; } else if (hs < 28) { type = 0; gi = 0; }
    else if (hs < 32) { type = 2; gi = 4; } else if (hs < 34) { type = 2; gi = 5; } else { type = 0; gi = 0; }
}
__device__ __forceinline__ void phase_rope(const Ctx& F, const float* gain  ) {
    bf16_t* P = (bf16_t*)(F.ws + WS_P);
    const f32x2_t* tab = (const f32x2_t*)(F.ws + WS_ROPE);
    const int s = F.lane & 7;
    for (int tok = F.gw; tok < MTOK; tok += F.NGW) {
        const int pos = tok & (SEQ - 1);
        bf16_t* row = P + (size_t)tok * PW;
#pragma unroll 1
        for (int pass = 0; pass < 5; ++pass) {
            const int hs_raw = pass * 8 + (F.lane >> 3); const int hs = hs_raw < 36 ? hs_raw : 35;
            int type, gi; head_info(hs, type, gi);
            const u32x4 raw = *(const u32x4*)(row + hs * 64 + s * 8);
            float x[8]; x[0] = bf_lo(raw.x); x[1] = bf_hi(raw.x); x[2] = bf_lo(raw.y); x[3] = bf_hi(raw.y); x[4] = bf_lo(raw.z); x[5] = bf_hi(raw.z); x[6] = bf_lo(raw.w); x[7] = bf_hi(raw.w);
            float ss = 0.f;
#pragma unroll
            for (int e = 0; e < 8; ++e) ss += x[e] * x[e];
            ss += __shfl_xor(ss, 1); ss += __shfl_xor(ss, 2); ss += __shfl_xor(ss, 4);
            const float rs = rsqrtf(ss * (1.0f / 64.0f) + EPS);
            const f32x4 g0 = *(const f32x4*)(gain + gi * 64 + s * 8), g1 = *(const f32x4*)(gain + gi * 64 + s * 8 + 4);
            float y[8]; y[0] = x[0] * rs * g0.x; y[1] = x[1] * rs * g0.y; y[2] = x[2] * rs * g0.z; y[3] = x[3] * rs * g0.w; y[4] = x[4] * rs * g1.x; y[5] = x[5] * rs * g1.y; y[6] = x[6] * rs * g1.z; y[7] = x[7] * rs * g1.w;
            const bool one_d = (type == 2);
            const int tbase = one_d ? 8 * (s & 3) : 32 + (s >> 2) * 16 + 8 * (s & 1);
            const bool isx1 = one_d ? (s < 4) : ((s & 2) == 0);
            const float qs = (gi == 0 || gi == 2 || gi == 4) ? QSCALE : 1.0f;
            float o[8];
#pragma unroll
            for (int e = 0; e < 8; ++e) {
                const float o4 = __shfl_xor(y[e], 4), o2 = __shfl_xor(y[e], 2);
                const float oth = one_d ? o4 : o2;
                const f32x2_t cs = tab[pos * 64 + tbase + e];
                o[e] = (isx1 ? (y[e] * cs.x - oth * cs.y) : (oth * cs.y + y[e] * cs.x)) * qs;
            }
            if (type != 0 && hs_raw < 36) {
                u32x4 w; w.x = cvtpk(o[0], o[1]); w.y = cvtpk(o[2], o[3]); w.z = cvtpk(o[4], o[5]); w.w = cvtpk(o[6], o[7]);
                *(u32x4*)(row + hs * 64 + s * 8) = w;
            }
        }
    }
}

struct AUnit {
    const bf16_t* q; const bf16_t* k; const bf16_t* v;
    bf16_t* o; float* lse;
    int ostride, btok, r, c, pair, pos0, T0, T1, W, has_sink; float sink2;
};
constexpr int ATT_KV = 0, ATT_WSF = 32768, ATT_OST = 34816;

__device__ __forceinline__ void attn_unit(const AUnit& U, LAS unsigned char* lds, int tid) {
    const int lane = tid & 63, r32 = lane & 31, hi = lane >> 5; const int wid = __builtin_amdgcn_readfirstlane(tid >> 6);
    const int sub = U.pair ? (wid >> 2) : 0;
    const int ipos0 = U.pair ? 32 * (wid & 3) : U.pos0 + 32 * wid;
    const int myi = ipos0 + r32;
    const int tokq0 = U.btok + U.c + sub;
    int wt0, wt1;
    if (U.pair) { wt0 = 2 * sub; wt1 = wt0 + 2; }
    else if (U.W >= 0) { wt0 = max(U.T0, (ipos0 - U.W) >> 6); wt1 = min(U.T1, ((ipos0 + 31 + U.W) >> 6) + 1); }
    else { wt0 = U.T0; wt1 = U.T1; }
    bf16x8 qr[4];
    { const bf16_t* qp = U.q + (size_t)(tokq0 + myi * U.r) * PW + hi * 8;
#pragma unroll
      for (int d0 = 0; d0 < 4; ++d0) qr[d0] = *(const bf16x8*)(qp + d0 * 16); }
    const int vkey = 16 * (wid & 3) + (lane >> 2);
    const int kcol = wid * 8, vcol = (wid >> 2) * 32 + (lane & 3) * 8;
    const unsigned stoff = (unsigned)wid * 1024u + (unsigned)lane * 16u;
#define ATT_TOK(t, key) (U.pair ? (U.btok + U.c + ((t) >> 1) + (64 * ((t) & 1) + (key)) * 16) : (U.btok + U.c + (64 * (t) + (key)) * U.r))
    LAS float* wsf = (LAS float*)(lds + ATT_WSF) + wid * 64;
    float m = U.has_sink ? U.sink2 : -1e30f;
    float l = (U.has_sink && hi == 0) ? 1.0f : 0.0f;
    f32x16 o0 = {}, o1 = {};
    u32x4 kreg, vreg;
    kreg = *(const u32x4*)(U.k + (size_t)ATT_TOK(U.T0, lane) * PW + kcol);
    vreg = *(const u32x4*)(U.v + (size_t)ATT_TOK(U.T0, vkey) * PW + vcol);
    *(LAS u32x4*)(lds + ATT_KV + stoff) = kreg;
    *(LAS u32x4*)(lds + ATT_KV + 8192 + stoff) = vreg;
    __syncthreads();
    for (int t = U.T0; t < U.T1; ++t) {
        const int cur = (t - U.T0) & 1;
        const bool more = (t + 1 < U.T1);
        if (more) {
            kreg = *(const u32x4*)(U.k + (size_t)ATT_TOK(t + 1, lane) * PW + kcol);
            vreg = *(const u32x4*)(U.v + (size_t)ATT_TOK(t + 1, vkey) * PW + vcol);
        }
        if (t >= wt0 && t < wt1) {
            LAS const unsigned char* kb = lds + ATT_KV + cur * 16384 + hi * 1024 + r32 * 16;
            f32x16 p0 = {}, p1 = {};
#pragma unroll
            for (int d0 = 0; d0 < 4; ++d0) {
                const bf16x8 b0 = *(LAS const bf16x8*)(kb + d0 * 2048);
                const bf16x8 b1 = *(LAS const bf16x8*)(kb + d0 * 2048 + 512);
                p0 = __builtin_amdgcn_mfma_f32_32x32x16_bf16(b0, qr[d0], p0, 0, 0, 0);
                p1 = __builtin_amdgcn_mfma_f32_32x32x16_bf16(b1, qr[d0], p1, 0, 0, 0);
            }
            if (U.W >= 0) {
                const int jb = (U.pair ? 64 * (t & 1) : 64 * t) + 4 * hi;
                const int lo = myi - U.W - jb, hb = myi + U.W - jb;
#pragma unroll
                for (int r = 0; r < 16; ++r) {
                    const int jr = (r & 3) + 8 * (r >> 2);
                    if (jr < lo || jr > hb) p0[r] = -INFINITY;
                    if (jr + 32 < lo || jr + 32 > hb) p1[r] = -INFINITY;
                }
            }
            float mx = fmaxf(p0[0], p1[0]);
#pragma unroll
            for (int r = 1; r < 16; ++r) mx = fmax3(mx, p0[r], p1[r]);
            { auto rr = __builtin_amdgcn_permlane32_swap(__float_as_uint(mx), __float_as_uint(mx), false, false); mx = fmaxf(__uint_as_float(rr[0]), __uint_as_float(rr[1])); }
            const float mnew = fmaxf(m, mx);
            if (__any(mnew > m)) {
                const float alpha = __builtin_amdgcn_exp2f(m - mnew);
                l *= alpha;
                if (hi == 0) wsf[r32] = alpha;
                m = mnew;
#pragma unroll
                for (int r = 0; r < 16; ++r) { const float a = wsf[crow(r, hi)]; o0[r] *= a; o1[r] *= a; }
            }
            float rsum = 0.f;
#pragma unroll
            for (int r = 0; r < 16; ++r) { p0[r] = __builtin_amdgcn_exp2f(p0[r] - m); p1[r] = __builtin_amdgcn_exp2f(p1[r] - m); rsum += p0[r] + p1[r]; }
            l += rsum;
            u32x4 pw0, pw1, pw2, pw3;
            pw0.x = cvtpk(p0[0], p0[1]); pw0.y = cvtpk(p0[2], p0[3]); pw0.z = cvtpk(p0[4], p0[5]); pw0.w = cvtpk(p0[6], p0[7]);
            pw1.x = cvtpk(p0[8], p0[9]); pw1.y = cvtpk(p0[10], p0[11]); pw1.z = cvtpk(p0[12], p0[13]); pw1.w = cvtpk(p0[14], p0[15]);
            pw2.x = cvtpk(p1[0], p1[1]); pw2.y = cvtpk(p1[2], p1[3]); pw2.z = cvtpk(p1[4], p1[5]); pw2.w = cvtpk(p1[6], p1[7]);
            pw3.x = cvtpk(p1[8], p1[9]); pw3.y = cvtpk(p1[10], p1[11]); pw3.z = cvtpk(p1[12], p1[13]); pw3.w = cvtpk(p1[14], p1[15]);
            LAS const unsigned char* vp = lds + ATT_KV + cur * 16384 + 8192 + ((lane >> 4) & 1) * 32 + (lane & 3) * 8 + (4 * hi + ((lane & 15) >> 2)) * 64;
#define ATT_TR(off) __builtin_bit_cast(s16x4, __builtin_amdgcn_ds_read_tr16_b64_v4i16((LAS s16x4*)(vp + (off))))
#define ATT_PV(oacc, d0, ks, pw) do { const s16x4 lo_ = ATT_TR((d0) * 4096 + (ks) * 1024), hi_ = ATT_TR((d0) * 4096 + (ks) * 1024 + 512); \
                const bf16x8 vf_ = (bf16x8){lo_[0], lo_[1], lo_[2], lo_[3], hi_[0], hi_[1], hi_[2], hi_[3]}; \
                oacc = __builtin_amdgcn_mfma_f32_32x32x16_bf16(__builtin_bit_cast(bf16x8, pw), vf_, oacc, 0, 0, 0); } while (0)
            ATT_PV(o0, 0, 0, pw0); ATT_PV(o1, 1, 0, pw0);
            ATT_PV(o0, 0, 1, pw1); ATT_PV(o1, 1, 1, pw1);
            ATT_PV(o0, 0, 2, pw2); ATT_PV(o1, 1, 2, pw2);
            ATT_PV(o0, 0, 3, pw3); ATT_PV(o1, 1, 3, pw3);
#undef ATT_PV
#undef ATT_TR
        }
        if (more) {
            *(LAS u32x4*)(lds + ATT_KV + (cur ^ 1) * 16384 + stoff) = kreg;
            *(LAS u32x4*)(lds + ATT_KV + (cur ^ 1) * 16384 + 8192 + stoff) = vreg;
        }
        __syncthreads();
    }
#undef ATT_TOK
    float ltot;
    { auto rr = __builtin_amdgcn_permlane32_swap(__float_as_uint(l), __float_as_uint(l), false, false); ltot = __uint_as_float(rr[0]) + __uint_as_float(rr[1]); }
    if (hi == 0) wsf[r32] = 1.0f / ltot;
    LAS bf16_t* stg = (LAS bf16_t*)(lds + ATT_OST) + wid * 2048;
#pragma unroll
    for (int r = 0; r < 16; ++r) {
        const int orow = crow(r, hi); const float rl = wsf[orow];
        stg[orow * 64 + r32] = (bf16_t)(cvtpk(o0[r] * rl, 0.f) & 0xffffu);
        stg[orow * 64 + 32 + r32] = (bf16_t)(cvtpk(o1[r] * rl, 0.f) & 0xffffu);
    }
#pragma unroll
    for (int i = 0; i < 4; ++i) {
        const int row = i * 8 + (lane >> 3), ch = lane & 7;
        const u32x4 v = *(LAS const u32x4*)(stg + row * 64 + ch * 8);
        *(u32x4*)(U.o + (size_t)(tokq0 + (ipos0 + row) * U.r) * U.ostride + ch * 8) = v;
    }
    if (U.lse != nullptr && hi == 0) U.lse[(size_t)(tokq0 + myi * U.r) * 6] = m + __builtin_amdgcn_logf(ltot);
}

__device__ __forceinline__ void phase_attn(const Ctx& F, const float* sink  ) {
    const bf16_t* P = (const bf16_t*)(F.ws + WS_P);
    bf16_t* MIX = (bf16_t*)(F.ws + WS_MIX); bf16_t* OB = (bf16_t*)(F.ws + WS_OB); float* LSE = (float*)(F.ws + WS_LSE);
    constexpr int NU = 768 * 4 + 512;
    for (int u = F.vcu; u < NU; u += F.G) {
        AUnit U; U.lse = nullptr; U.r = 1; U.c = 0; U.pair = 0; U.W = -1; U.has_sink = 0; U.sink2 = 0.f;
        if (u < 768) {
            const int b = u / 48, h = (u >> 3) % 6, qb = u & 7;
            U.q = P + C_QA + h * 64; U.k = P + C_KA + (h / 3) * 64; U.v = P + C_VA + (h / 3) * 64; U.o = MIX + h * 64; U.ostride = DM;
            U.btok = b * SEQ; U.pos0 = 256 * qb; U.T0 = 0; U.T1 = 32;
        } else if (u < 3072) {
            const int br = (u - 768) / 768, uu = (u - 768) % 768;
            const int b = uu / 48, h = (uu >> 3) % 6, x = uu & 7;
            U.q = P + C_QB + h * 64; U.k = P + C_KB + h * 64; U.v = P + C_VB + h * 64; U.o = OB + (size_t)br * MTOK * 384 + h * 64; U.ostride = 384;
            U.lse = LSE + (size_t)br * MTOK * 6 + h; U.btok = b * SEQ; U.W = 64;
            if (br == 0) { U.pos0 = 256 * x; U.T0 = max(0, 4 * x - 1); U.T1 = min(32, 4 * x + 5); }
            else if (br == 1) { const int qb = x & 1; U.r = 4; U.c = x >> 1; U.pos0 = 256 * qb; U.T0 = max(0, 4 * qb - 1); U.T1 = min(8, 4 * qb + 5); }
            else { U.r = 16; U.c = 2 * x; U.pair = 1; U.pos0 = 0; U.T0 = 0; U.T1 = 4; }
        } else {
            const int uu = u - 3072; const int b = uu / 32, h = (uu >> 3) & 3, qb = uu & 7;
            U.q = P + C_QC + h * 64; U.k = P + C_KC + (h >> 1) * 64; U.v = P + C_VC + (h >> 1) * 64; U.o = MIX + 768 + h * 64; U.ostride = DM;
            U.btok = b * SEQ; U.pos0 = 256 * qb; U.W = 128; U.T0 = max(0, 4 * qb - 2); U.T1 = min(32, 4 * qb + 6);
            U.has_sink = 1; U.sink2 = sink[h] * LOG2E;
        }
        attn_unit(U, F.lds, F.tid);
    }
}

__device__ __forceinline__ void unpack8(const u32x4 w, float (&x)[8]) { x[0] = bf_lo(w.x); x[1] = bf_hi(w.x); x[2] = bf_lo(w.y); x[3] = bf_hi(w.y); x[4] = bf_lo(w.z); x[5] = bf_hi(w.z); x[6] = bf_lo(w.w); x[7] = bf_hi(w.w); }
__device__ __forceinline__ void phase_post(const Ctx& F, const float* g  ) {
    const bf16_t* MIX = (const bf16_t*)(F.ws + WS_MIX); const bf16_t* OB = (const bf16_t*)(F.ws + WS_OB); const float* LSE = (const float*)(F.ws + WS_LSE);
    bf16_t* H = (bf16_t*)(F.ws + WS_H);
    const int lane = F.lane; const int l48 = lane < 48 ? lane : 47, l32 = lane < 32 ? lane : 31;
    for (int tok = F.gw; tok < MTOK; tok += F.NGW) {
        float a[8], bsum[8], c[8];
        unpack8(*(const u32x4*)(MIX + (size_t)tok * DM + l48 * 8), a);
        unpack8(*(const u32x4*)(MIX + (size_t)tok * DM + 768 + l32 * 8), c);
        const int h = l48 >> 3;
        const float ls0 = LSE[(size_t)tok * 6 + h], ls1 = LSE[(size_t)(MTOK + tok) * 6 + h], ls2 = LSE[(size_t)(2 * MTOK + tok) * 6 + h];
        const float mxl = fmax3(ls0, ls1, ls2);
        float w0 = __builtin_amdgcn_exp2f(ls0 - mxl), w1 = __builtin_amdgcn_exp2f(ls1 - mxl), w2 = __builtin_amdgcn_exp2f(ls2 - mxl);
        const float inv = 1.0f / (w0 + w1 + w2); w0 *= inv; w1 *= inv; w2 *= inv;
        { float t0[8], t1[8], t2[8];
          unpack8(*(const u32x4*)(OB + (size_t)tok * 384 + l48 * 8), t0);
          unpack8(*(const u32x4*)(OB + (size_t)(MTOK + tok) * 384 + l48 * 8), t1);
          unpack8(*(const u32x4*)(OB + (size_t)(2 * MTOK + tok) * 384 + l48 * 8), t2);
#pragma unroll
          for (int e = 0; e < 8; ++e) bsum[e] = w0 * t0[e] + w1 * t1[e] + w2 * t2[e]; }
        float sa = 0.f, sb = 0.f, sc = 0.f;
#pragma unroll
        for (int e = 0; e < 8; ++e) { sa += a[e] * a[e]; sb += bsum[e] * bsum[e]; sc += c[e] * c[e]; }
        if (lane >= 48) { sa = 0.f; sb = 0.f; }
        if (lane >= 32) sc = 0.f;
        sa = wave_sum(sa); sb = wave_sum(sb); sc = wave_sum(sc);
        const float ra = rsqrtf(sa * (1.0f / 384.0f) + EPS), rb = rsqrtf(sb * (1.0f / 384.0f) + EPS), rc = rsqrtf(sc * (1.0f / 256.0f) + EPS);
        if (lane < 48) {
            const f32x4 g0 = *(const f32x4*)(g + lane * 8), g1 = *(const f32x4*)(g + lane * 8 + 4);
            u32x4 w; w.x = cvtpk(a[0] * ra * g0.x, a[1] * ra * g0.y); w.y = cvtpk(a[2] * ra * g0.z, a[3] * ra * g0.w); w.z = cvtpk(a[4] * ra * g1.x, a[5] * ra * g1.y); w.w = cvtpk(a[6] * ra * g1.z, a[7] * ra * g1.w);
            *(u32x4*)(H + (size_t)tok * DM + lane * 8) = w;
            const f32x4 h0 = *(const f32x4*)(g + 384 + lane * 8), h1 = *(const f32x4*)(g + 384 + lane * 8 + 4);
            u32x4 v; v.x = cvtpk(bsum[0] * rb * h0.x, bsum[1] * rb * h0.y); v.y = cvtpk(bsum[2] * rb * h0.z, bsum[3] * rb * h0.w); v.z = cvtpk(bsum[4] * rb * h1.x, bsum[5] * rb * h1.y); v.w = cvtpk(bsum[6] * rb * h1.z, bsum[7] * rb * h1.w);
            *(u32x4*)(H + (size_t)tok * DM + 384 + lane * 8) = v;
        }
        if (lane < 32) {
            const f32x4 g0 = *(const f32x4*)(g + 768 + lane * 8), g1 = *(const f32x4*)(g + 768 + lane * 8 + 4);
            u32x4 w; w.x = cvtpk(c[0] * rc * g0.x, c[1] * rc * g0.y); w.y = cvtpk(c[2] * rc * g0.z, c[3] * rc * g0.w); w.z = cvtpk(c[4] * rc * g1.x, c[5] * rc * g1.y); w.w = cvtpk(c[6] * rc * g1.z, c[7] * rc * g1.w);
            *(u32x4*)(H + (size_t)tok * DM + 768 + lane * 8) = w;
        }
    }
}

__device__ __forceinline__ void phase_route(const Ctx& F, int layer) {
    const bf16_t* Q = (const bf16_t*)(F.ws + WS_Q);
    const bf16_t* KEYS = (const bf16_t*)(F.ws + WS_KEYS) + (size_t)layer * 8 * 2 * 128 * 64;
    unsigned short* IDX = (unsigned short*)(F.ws + WS_IDX); float* GATE = (float*)(F.ws + WS_GATE);
    const int lane = F.lane, c = lane & 15, g = lane >> 4;
    for (int unit = F.gw; unit < MTOK / 16; unit += F.NGW) {
        const int tok = unit * 16 + c;
        const bf16_t* qrow = Q + (size_t)tok * DM + g * 8;
#pragma unroll 1
        for (int h = 0; h < 8; ++h) {
            float sv0[16], sv1[16];
#pragma unroll
            for (int p = 0; p < 2; ++p) {
                const bf16x8 bq0 = *(const bf16x8*)(qrow + h * 128 + p * 64), bq1 = *(const bf16x8*)(qrow + h * 128 + p * 64 + 32);
                const bf16_t* kb = KEYS + (size_t)((h * 2 + p) * 128 + c) * 64 + g * 8;
                float v[32];
#pragma unroll
                for (int kt = 0; kt < 8; ++kt) {
                    const bf16x8 a0 = *(const bf16x8*)(kb + kt * 16 * 64), a1 = *(const bf16x8*)(kb + kt * 16 * 64 + 32);
                    f32x4 acc = {0.f, 0.f, 0.f, 0.f};
                    acc = __builtin_amdgcn_mfma_f32_16x16x32_bf16(a0, bq0, acc, 0, 0, 0);
                    acc = __builtin_amdgcn_mfma_f32_16x16x32_bf16(a1, bq1, acc, 0, 0, 0);
#pragma unroll
                    for (int r = 0; r < 4; ++r) v[kt * 4 + r] = __uint_as_float((__float_as_uint(acc[r]) & 0xFFFFFF80u) | (unsigned)(kt * 16 + r) | (unsigned)(4 * g));
                }
#pragma unroll
                for (int k = 0; k < 16; ++k) {
                    float mloc = fmaxf(v[0], v[1]);
#pragma unroll
                    for (int i = 2; i < 32; i += 2) mloc = fmax3(mloc, v[i], v[i + 1]);
                    mloc = fmaxf(mloc, __shfl_xor(mloc, 16)); mloc = fmaxf(mloc, __shfl_xor(mloc, 32));
                    if (p == 0) sv0[k] = mloc; else sv1[k] = mloc;
#pragma unroll
                    for (int i = 0; i < 32; ++i) v[i] = (v[i] == mloc) ? -INFINITY : v[i];
                }
            }
            float t[4];
#pragma unroll
            for (int j = 0; j < 4; ++j) t[j] = (g == 0) ? sv1[4 * j] : (g == 1) ? sv1[4 * j + 1] : (g == 2) ? sv1[4 * j + 2] : sv1[4 * j + 3];
            float cv[21];
#define CAND(slot, a, j) cv[slot] = __uint_as_float((__float_as_uint(sv0[a] + t[j]) & 0xFFFFC000u) | ((__float_as_uint(sv0[a]) & 0x7Fu) << 7) | (__float_as_uint(t[j]) & 0x7Fu))
#pragma unroll
            for (int a = 0; a < 16; ++a) CAND(a, a, 0);
            CAND(16, 0, 1); CAND(17, 1, 1); CAND(18, 2, 1); CAND(19, 0, 2); CAND(20, 0, 3);
#undef CAND
            float w[16];
#pragma unroll
            for (int k = 0; k < 16; ++k) {
                float mloc = cv[0];
#pragma unroll
                for (int i = 1; i < 21; i += 2) mloc = fmax3(mloc, cv[i], cv[i + 1]);
                mloc = fmaxf(mloc, __shfl_xor(mloc, 16)); mloc = fmaxf(mloc, __shfl_xor(mloc, 32));
                w[k] = mloc;
#pragma unroll
                for (int i = 0; i < 21; ++i) cv[i] = (cv[i] == mloc) ? -INFINITY : cv[i];
            }
            float e[16]; float den = 0.f;
#pragma unroll
            for (int k = 0; k < 16; ++k) { e[k] = __builtin_amdgcn_exp2f((w[k] - w[0]) * LOG2E); den += e[k]; }
            const float inv = 1.0f / den;
            if (g == 0) {
                unsigned iw[8];
#pragma unroll
                for (int k = 0; k < 8; ++k) iw[k] = (__float_as_uint(w[2 * k]) & 0x3FFFu) | ((__float_as_uint(w[2 * k + 1]) & 0x3FFFu) << 16);
                u32x4* ip = (u32x4*)(IDX + (size_t)tok * 128 + h * 16);
                ip[0] = (u32x4){iw[0], iw[1], iw[2], iw[3]}; ip[1] = (u32x4){iw[4], iw[5], iw[6], iw[7]};
                f32x4* gp = (f32x4*)(GATE + (size_t)tok * 128 + h * 16);
#pragma unroll
                for (int k = 0; k < 4; ++k) gp[k] = (f32x4){e[4 * k] * inv, e[4 * k + 1] * inv, e[4 * k + 2] * inv, e[4 * k + 3] * inv};
            }
        }
    }
}

__device__ __forceinline__ float dot8(const u32x4 w, const float* x) {
    return bf_lo(w.x) * x[0] + bf_hi(w.x) * x[1] + bf_lo(w.y) * x[2] + bf_hi(w.y) * x[3] + bf_lo(w.z) * x[4] + bf_hi(w.z) * x[5] + bf_lo(w.w) * x[6] + bf_hi(w.w) * x[7];
}
__device__ __forceinline__ void fma8(float* o, const u32x4 w, float a) {
    o[0] += a * bf_lo(w.x); o[1] += a * bf_hi(w.x); o[2] += a * bf_lo(w.y); o[3] += a * bf_hi(w.y); o[4] += a * bf_lo(w.z); o[5] += a * bf_hi(w.z); o[6] += a * bf_lo(w.w); o[7] += a * bf_hi(w.w);
}
__device__ __forceinline__ void phase_gather(const Ctx& F, int layer) {
    const bf16_t* Ut = (const bf16_t*)(F.ws + WS_U) + (size_t)layer * NEXP * DM;
    const bf16_t* Vt = (const bf16_t*)(F.ws + WS_V) + (size_t)layer * NEXP * DM;
    const unsigned short* IDX = (const unsigned short*)(F.ws + WS_IDX); const float* GATE = (const float*)(F.ws + WS_GATE);
    const float* gn = F.in[7] + (size_t)layer * DM;
    const float* gnext = F.in[1] + (size_t)(layer + 1 < DEPTH ? layer + 1 : 0) * DM;
    const int lane = F.lane;
    const int b5 = lane & 32, b4 = lane & 16, b3 = lane & 8;
    for (int tok = F.gw; tok < MTOK; tok += F.NGW) {
        float* xr = F.out + (size_t)tok * DM;
        float x[16], xh[16];
        { const f32x4 a0 = *(const f32x4*)(xr + 8 * lane), a1 = *(const f32x4*)(xr + 8 * lane + 4), c0 = *(const f32x4*)(xr + 512 + 8 * lane), c1 = *(const f32x4*)(xr + 512 + 8 * lane + 4);
          x[0] = a0.x; x[1] = a0.y; x[2] = a0.z; x[3] = a0.w; x[4] = a1.x; x[5] = a1.y; x[6] = a1.z; x[7] = a1.w;
          x[8] = c0.x; x[9] = c0.y; x[10] = c0.z; x[11] = c0.w; x[12] = c1.x; x[13] = c1.y; x[14] = c1.z; x[15] = c1.w; }
        float ss = 0.f;
#pragma unroll
        for (int i = 0; i < 16; ++i) ss += x[i] * x[i];
        const float rs = rsqrtf(wave_sum(ss) * (1.0f / DM) + EPS);
        { const f32x4 a0 = *(const f32x4*)(gn + 8 * lane), a1 = *(const f32x4*)(gn + 8 * lane + 4), c0 = *(const f32x4*)(gn + 512 + 8 * lane), c1 = *(const f32x4*)(gn + 512 + 8 * lane + 4);
          xh[0] = x[0] * rs * a0.x; xh[1] = x[1] * rs * a0.y; xh[2] = x[2] * rs * a0.z; xh[3] = x[3] * rs * a0.w; xh[4] = x[4] * rs * a1.x; xh[5] = x[5] * rs * a1.y; xh[6] = x[6] * rs * a1.z; xh[7] = x[7] * rs * a1.w;
          xh[8] = x[8] * rs * c0.x; xh[9] = x[9] * rs * c0.y; xh[10] = x[10] * rs * c0.z; xh[11] = x[11] * rs * c0.w; xh[12] = x[12] * rs * c1.x; xh[13] = x[13] * rs * c1.y; xh[14] = x[14] * rs * c1.z; xh[15] = x[15] * rs * c1.w; }
        const unsigned idxreg = ((const unsigned*)(IDX + (size_t)tok * 128))[lane];
        const int pslot = 8 * (lane & 7) + (lane >> 3);
        const float gate0 = GATE[(size_t)tok * 128 + pslot], gate1 = GATE[(size_t)tok * 128 + 64 + pslot];
        float z0 = 0.f, z1 = 0.f;
#pragma unroll 1
        for (int s0 = 0; s0 < 128; s0 += 8) {
            u32x4 ua[8], ub[8];
#pragma unroll
            for (int j = 0; j < 8; ++j) {
                const unsigned wv = (unsigned)__builtin_amdgcn_readlane((int)idxreg, (s0 >> 1) + (j >> 1));
                const unsigned e = (j & 1) ? (wv >> 16) : (wv & 0xffffu);
                const bf16_t* row = Ut + (size_t)e * DM + 8 * lane;
                ua[j] = *(const u32x4*)row; ub[j] = *(const u32x4*)(row + 512);
            }
            float p[8];
#pragma unroll
            for (int j = 0; j < 8; ++j) p[j] = dot8(ua[j], xh) + dot8(ub[j], xh + 8);
            float q4[4], r2[2];
#pragma unroll
            for (int j = 0; j < 4; ++j) { const float send = b5 ? p[j] : p[j + 4], keep = b5 ? p[j + 4] : p[j]; q4[j] = keep + __shfl_xor(send, 32); }
#pragma unroll
            for (int j = 0; j < 2; ++j) { const float send = b4 ? q4[j] : q4[j + 2], keep = b4 ? q4[j + 2] : q4[j]; r2[j] = keep + __shfl_xor(send, 16); }
            float wv_;
            { const float send = b3 ? r2[0] : r2[1], keep = b3 ? r2[1] : r2[0]; wv_ = keep + __shfl_xor(send, 8); }
            wv_ += __shfl_xor(wv_, 4); wv_ += __shfl_xor(wv_, 2); wv_ += __shfl_xor(wv_, 1);
            if ((lane & 7) == ((s0 >> 3) & 7)) { if (s0 < 64) z0 = wv_; else z1 = wv_; }
        }
        const float act0 = 0.5f * z0 * (1.0f + erff(z0 * 0.70710678118654752f)) * gate0;
        const float act1 = 0.5f * z1 * (1.0f + erff(z1 * 0.70710678118654752f)) * gate1;
        float o[16];
#pragma unroll
        for (int i = 0; i < 16; ++i) o[i] = 0.f;
#pragma unroll 1
        for (int s0 = 0; s0 < 128; s0 += 8) {
            u32x4 va[8], vb[8];
#pragma unroll
            for (int j = 0; j < 8; ++j) {
                const unsigned wv = (unsigned)__builtin_amdgcn_readlane((int)idxreg, (s0 >> 1) + (j >> 1));
                const unsigned e = (j & 1) ? (wv >> 16) : (wv & 0xffffu);
                const bf16_t* row = Vt + (size_t)e * DM + 8 * lane;
                va[j] = *(const u32x4*)row; vb[j] = *(const u32x4*)(row + 512);
            }
            const float asel = (s0 < 64) ? act0 : act1;
#pragma unroll
            for (int j = 0; j < 8; ++j) {
                const float a = __uint_as_float((unsigned)__builtin_amdgcn_readlane((int)__float_as_uint(asel), 8 * j + ((s0 >> 3) & 7)));
                fma8(o, va[j], a); fma8(o + 8, vb[j], a);
            }
        }
#pragma unroll
        for (int i = 0; i < 16; ++i) x[i] += o[i];
        *(f32x4*)(xr + 8 * lane) = (f32x4){x[0], x[1], x[2], x[3]}; *(f32x4*)(xr + 8 * lane + 4) = (f32x4){x[4], x[5], x[6], x[7]};
        *(f32x4*)(xr + 512 + 8 * lane) = (f32x4){x[8], x[9], x[10], x[11]}; *(f32x4*)(xr + 512 + 8 * lane + 4) = (f32x4){x[12], x[13], x[14], x[15]};
        if (layer + 1 < DEPTH) {
            float s2 = 0.f;
#pragma unroll
            for (int i = 0; i < 16; ++i) s2 += x[i] * x[i];
            const float rs2 = rsqrtf(wave_sum(s2) * (1.0f / DM) + EPS);
            const f32x4 a0 = *(const f32x4*)(gnext + 8 * lane), a1 = *(const f32x4*)(gnext + 8 * lane + 4), c0 = *(const f32x4*)(gnext + 512 + 8 * lane), c1 = *(const f32x4*)(gnext + 512 + 8 * lane + 4);
            bf16_t* hr = (bf16_t*)(F.ws + WS_H) + (size_t)tok * DM;
            u32x4 w0, w1;
            w0.x = cvtpk(x[0] * rs2 * a0.x, x[1] * rs2 * a0.y); w0.y = cvtpk(x[2] * rs2 * a0.z, x[3] * rs2 * a0.w); w0.z = cvtpk(x[4] * rs2 * a1.x, x[5] * rs2 * a1.y); w0.w = cvtpk(x[6] * rs2 * a1.z, x[7] * rs2 * a1.w);
            w1.x = cvtpk(x[8] * rs2 * c0.x, x[9] * rs2 * c0.y); w1.y = cvtpk(x[10] * rs2 * c0.z, x[11] * rs2 * c0.w); w1.z = cvtpk(x[12] * rs2 * c1.x, x[13] * rs2 * c1.y); w1.w = cvtpk(x[14] * rs2 * c1.z, x[15] * rs2 * c1.w);
            *(u32x4*)(hr + 8 * lane) = w0; *(u32x4*)(hr + 512 + 8 * lane) = w1;
        }
    }
}

constexpr int N_PHASES = 1 + 9 * DEPTH;
struct Args { const float* in[12]; float* out; unsigned char* ws; int ph_lo, ph_hi; };
__global__ void __launch_bounds__(NTHREADS, 2) mk_fwd(Args args) {
    extern __shared__ __attribute__((aligned(16))) unsigned char lds_raw[];
#define MKCTX() Ctx F; { int t_ = threadIdx.x, b_ = blockIdx.x; asm volatile("" : "+v"(t_)); asm volatile("" : "+s"(b_)); \
        F.lds = (LAS unsigned char*)lds_raw; F.tid = t_; F.lane = t_ & 63; F.wave = __builtin_amdgcn_readfirstlane(t_ >> 6); F.G = gridDim.x; \
        F.vcu = (F.G % 8 == 0) ? (b_ % 8) * (F.G / 8) + b_ / 8 : b_; F.gw = F.vcu * NWAVES + F.wave; F.NGW = F.G * NWAVES; F.in = args.in; F.out = args.out; F.ws = args.ws; }
    const int lo = args.ph_lo, hi = args.ph_hi;
#define IN(k) (lo <= (k) && (k) < hi)
#define SEAM(k) do { if (IN(k) && IN((k) + 1)) { cg::this_grid().sync(); } } while (0)
    if (IN(0)) { MKCTX(); phase_p0(F); } SEAM(0);
#pragma unroll 1
    for (int l = 0; l < DEPTH; ++l) {
        const int pb = 1 + 9 * l;
        bf16_t* H = (bf16_t*)(args.ws + WS_H);
        if (IN(pb + 0)) {
            pg8::Gemm g{H, (const bf16_t*)(args.ws + WS_WIN) + (size_t)l * PW * DM, MTOK, PW, DM}; pg8::StaticOrder S; S.init(MTOK, PW, (int)gridDim.x, (int)blockIdx.x);
            pg8::EpiBf16 E{(bf16_t*)(args.ws + WS_P), PW};
            pg8::gemm_phase<pg8::EpiBf16, pg8::StaticOrder, true, true>((LAS unsigned char*)lds_raw, g, S, E);
        } SEAM(pb + 0);
        if (IN(pb + 1)) { MKCTX(); phase_rope(F, F.in[3] + l * 384); } SEAM(pb + 1);
        if (IN(pb + 2)) { MKCTX(); phase_attn(F, F.in[4] + l * 4); } SEAM(pb + 2);
        if (IN(pb + 3)) { MKCTX(); phase_post(F, F.in[5] + l * DM); } SEAM(pb + 3);
        if (IN(pb + 4)) {
            pg8::Gemm g{H, (const bf16_t*)(args.ws + WS_WOUT) + (size_t)l * DM * DM, MTOK, DM, DM}; pg8::StaticOrder S; S.init(MTOK, DM, (int)gridDim.x, (int)blockIdx.x);
            pg8::EpiResF32 E{l == 0 ? args.in[0] : args.out, args.out, DM};
            pg8::gemm_phase<pg8::EpiResF32, pg8::StaticOrder, true, true>((LAS unsigned char*)lds_raw, g, S, E);
        } SEAM(pb + 4);
        if (IN(pb + 5)) { MKCTX(); phase_norm(F, F.out, F.in[7] + l * DM); } SEAM(pb + 5);
        if (IN(pb + 6)) {
            pg8::Gemm g{H, (const bf16_t*)(args.ws + WS_WQ) + (size_t)l * DM * DM, MTOK, DM, DM}; pg8::StaticOrder S; S.init(MTOK, DM, (int)gridDim.x, (int)blockIdx.x);
            pg8::EpiBf16 E{(bf16_t*)(args.ws + WS_Q), DM};
            pg8::gemm_phase<pg8::EpiBf16, pg8::StaticOrder, true, true>((LAS unsigned char*)lds_raw, g, S, E);
        } SEAM(pb + 6);
        if (IN(pb + 7)) { MKCTX(); phase_route(F, l); } SEAM(pb + 7);
        if (IN(pb + 8)) { MKCTX(); phase_gather(F, l); } SEAM(pb + 8);
    }
#undef IN
#undef SEAM
}

#ifndef MK_ONE_LAUNCH
#define MK_ONE_LAUNCH 0
#endif
extern "C" void kernel_launch(void* const* d_in, const int* in_sizes, int n_in, void* d_out, int out_size, void* d_ws, size_t ws_size, hipStream_t stream) {
    static int grid = 0;
    if (grid == 0) {
        if (n_in != 12 || ws_size < WS_END) { fprintf(stderr, "kernel_launch: unexpected n_in %d / ws %zu\n", n_in, ws_size); grid = -1; return; }
        int dev = 0, cus = 0, per_cu = 0;
        if (hipGetDevice(&dev) != hipSuccess || hipDeviceGetAttribute(&cus, hipDeviceAttributeMultiprocessorCount, dev) != hipSuccess) { grid = -1; return; }
        if (hipFuncSetAttribute((const void*)mk_fwd, hipFuncAttributeMaxDynamicSharedMemorySize, LDS_BYTES) != hipSuccess) { fprintf(stderr, "kernel_launch: hipFuncSetAttribute failed\n"); grid = -1; return; }
        if (hipOccupancyMaxActiveBlocksPerMultiprocessor(&per_cu, (const void*)mk_fwd, NTHREADS, LDS_BYTES) != hipSuccess || per_cu < 1) { fprintf(stderr, "kernel_launch: occupancy query failed (%d)\n", per_cu); (void)hipGetLastError(); grid = -1; return; }
        grid = cus * per_cu;
        fprintf(stderr, "kernel_launch: cus %d per_cu %d grid %d\n", cus, per_cu, grid);
    }
    if (grid < 0) return;
    Args a{};
    for (int i = 0; i < 12; ++i) a.in[i] = (const float*)d_in[i];
    a.out = (float*)d_out; a.ws = (unsigned char*)d_ws;
#if MK_ONE_LAUNCH
    a.ph_lo = 0; a.ph_hi = N_PHASES;
    void* kargs[] = {&a};
    hipError_t e = hipLaunchCooperativeKernel((const void*)mk_fwd, dim3(grid), dim3(NTHREADS), kargs, LDS_BYTES, stream);
    if (e != hipSuccess) fprintf(stderr, "cooperative launch failed: %s (grid %d)\n", hipGetErrorString(e), grid);
#else
    for (int p = 0; p < N_PHASES; ++p) { a.ph_lo = p; a.ph_hi = p + 1; hipLaunchKernelGGL(mk_fwd, dim3(grid), dim3(NTHREADS), LDS_BYTES, stream, a); }
#endif
}
```

```cpp
#include <hip/hip_runtime.h>
#include <hip/hip_cooperative_groups.h>
#include <cstdio>
#include <cstdint>
#include <cmath>
namespace cg = cooperative_groups;

constexpr int BATCH = 16, SEQ = 2048, DM = 1024, DEPTH = 2;
constexpr int MTOK = BATCH * SEQ;
constexpr int PW = 2304;
constexpr int NKEYS = 128, NEXP = NKEYS * NKEYS;
constexpr float EPS = 1e-6f;
constexpr int C_QA = 0, C_KA = 384, C_VA = 512, C_QB = 640, C_KB = 1024, C_VB = 1408, C_QC = 1792, C_KC = 2048, C_VC = 2176;
constexpr float LOG2E = 1.4426950408889634f;
constexpr float QSCALE = 0.125f * LOG2E;

#define LAS __attribute__((address_space(3)))
typedef unsigned short bf16_t;
typedef short bf16x8 __attribute__((ext_vector_type(8)));
typedef short s16x4 __attribute__((ext_vector_type(4)));
typedef float f32x4 __attribute__((ext_vector_type(4)));
typedef float f32x16 __attribute__((ext_vector_type(16)));
typedef unsigned u32x4 __attribute__((ext_vector_type(4)));
typedef unsigned u32x2 __attribute__((ext_vector_type(2)));
typedef float f32x2_t __attribute__((ext_vector_type(2)));
typedef float f32x32 __attribute__((ext_vector_type(32)));
typedef unsigned u32x6 __attribute__((ext_vector_type(6)));
typedef u32x6 u32x6_a8 __attribute__((aligned(8)));
typedef __bf16 bf16x2_t __attribute__((ext_vector_type(2)));

__device__ __forceinline__ unsigned cvtpk(float lo, float hi) { f32x2_t v = {lo, hi}; bf16x2_t b = __builtin_convertvector(v, bf16x2_t); return __builtin_bit_cast(unsigned, b); }
__device__ __forceinline__ float bf_lo(unsigned w) { return __uint_as_float(w << 16); }
__device__ __forceinline__ float bf_hi(unsigned w) { return __uint_as_float(w & 0xffff0000u); }
template <int CTRL> __device__ __forceinline__ float dppf(float x) { return __uint_as_float((unsigned)__builtin_amdgcn_update_dpp(0, (int)__float_as_uint(x), CTRL, 0xF, 0xF, true)); }
#define DPP_XOR1 0xB1
#define DPP_XOR2 0x4E
#define DPP_XOR3 0x1B
#define DPP_HMIR 0x141
#define DPP_RMIR 0x140
__device__ __forceinline__ float swap16_sum(float a, float b) { auto r = __builtin_amdgcn_permlane16_swap(__float_as_uint(a), __float_as_uint(b), false, false); return __uint_as_float(r[0]) + __uint_as_float(r[1]); }
__device__ __forceinline__ float swap32_sum(float a, float b) { auto r = __builtin_amdgcn_permlane32_swap(__float_as_uint(a), __float_as_uint(b), false, false); return __uint_as_float(r[0]) + __uint_as_float(r[1]); }
__device__ __forceinline__ float swap16_max(float a) { auto r = __builtin_amdgcn_permlane16_swap(__float_as_uint(a), __float_as_uint(a), false, false); return fmaxf(__uint_as_float(r[0]), __uint_as_float(r[1])); }
__device__ __forceinline__ float swap32_max(float a) { auto r = __builtin_amdgcn_permlane32_swap(__float_as_uint(a), __float_as_uint(a), false, false); return fmaxf(__uint_as_float(r[0]), __uint_as_float(r[1])); }
__device__ __forceinline__ float wave_sum(float v) {
    v += dppf<DPP_XOR1>(v); v += dppf<DPP_XOR2>(v); v += dppf<DPP_HMIR>(v); v += dppf<DPP_RMIR>(v);
    v = swap16_sum(v, v); v = swap32_sum(v, v);
    return v;
}
__device__ __forceinline__ float wave_max(float v) {
    v = fmaxf(v, dppf<DPP_XOR1>(v)); v = fmaxf(v, dppf<DPP_XOR2>(v)); v = fmaxf(v, dppf<DPP_HMIR>(v)); v = fmaxf(v, dppf<DPP_RMIR>(v));
    v = swap16_max(v); v = swap32_max(v);
    return v;
}

constexpr size_t MiB = 1u << 20;
constexpr size_t WS_CTL = 0, CTL_BYTES = 1 * MiB;
constexpr size_t WS_WIN = 1 * MiB;
constexpr size_t WS_WOUT = 10 * MiB;
constexpr size_t WS_WQ = 14 * MiB;
constexpr size_t WS_KEYS = 18 * MiB;
constexpr size_t WS_LSE = 19 * MiB;
constexpr size_t WS_ROPE = 22 * MiB;
constexpr size_t WS_U = 24 * MiB;
constexpr size_t WS_V = 56 * MiB;
constexpr int ROWB = 768;
constexpr size_t WS_SU = 88 * MiB;
constexpr size_t WS_SV = 89 * MiB;
constexpr size_t WS_H = 152 * MiB;
constexpr size_t WS_P = 216 * MiB;
constexpr size_t WS_MIX = 360 * MiB;
constexpr size_t WS_OB = 424 * MiB;
constexpr size_t WS_END = 496 * MiB;
constexpr size_t WS_X1B = WS_MIX;
constexpr size_t WS_SSQ = 90 * MiB;
constexpr size_t WS_ACTG = WS_P + 96 * MiB;
constexpr size_t WS_Q = WS_P;
constexpr size_t WS_IDX = WS_P + 64 * MiB;
constexpr size_t WS_GATE = WS_P + 72 * MiB;

constexpr int NWAVES = 8, NTHREADS = 512;
constexpr int LDS_BYTES = 147456;

namespace pg8 {
using ::u32x2;
#define PG8_LAS __attribute__((address_space(3)))
typedef unsigned short bf16_t;
typedef short bf16x8 __attribute__((ext_vector_type(8)));
typedef float f32x4 __attribute__((ext_vector_type(4)));
typedef unsigned u32x4 __attribute__((ext_vector_type(4)));
constexpr int BM = 256, BK = 64, HALF = 128, HTB = HALF * BK * 2  , STAGE_BYTES = 8 * HTB, NXCD = 8, WGM = 8;

__host__ __device__ __forceinline__ int lds_byte(int r, int c) { const int st = (r >> 4) * 2 + (c >> 5), rr = r & 15, cc = c & 31, ob = rr * 64 + cc * 2; return st * 1024 + (ob ^ (((ob >> 9) & 1) << 5)); }
__host__ __device__ __forceinline__ void stage_rc(int b, int& R, int& C) { const int st = b / 1024, sb = b % 1024, swz = sb ^ (((sb >> 9) & 1) << 5); R = (st >> 1) * 16 + swz / 64; C = (st & 1) * 32 + (swz % 64) / 2; }
__host__ __device__ __forceinline__ int perm32(int rho) { const int n = rho >> 4, i = rho & 15; return 8 * (i >> 2) + 4 * n + (i & 3); }

struct Unit { int pm, pn; };
struct Gemm { const bf16_t* A; const bf16_t* Bt; int M, N, K; };

struct StaticOrder {
    int nM, nN, nwg, G, c;
    __host__ __device__ void init(int M, int N, int G_, int c_) { nM = M / BM; nN = N / BM; nwg = nM * nN; G = G_; c = c_; }
    __host__ __device__ bool next(int i, Unit& u) const {
        const long L = (long)i * G + c; if (L >= nwg) return false;
        int wgid = (int)L; { const int q = nwg / NXCD, r = nwg % NXCD, xcd = wgid % NXCD, off = wgid / NXCD; wgid = (xcd < r ? xcd * (q + 1) : r * (q + 1) + (xcd - r) * q) + off; }
        const int nig = WGM * nN, gid = wgid / nig, fm = gid * WGM, gsz = (nM - fm) < WGM ? (nM - fm) : WGM;
        u.pm = fm + ((wgid % nig) % gsz); u.pn = (wgid % nig) / gsz; return true;
    }
    __device__ __forceinline__ void a_ready(const Unit&) const {}
    __device__ __forceinline__ void done(const Unit&) const {}
};


struct EpiBf16 {
    static constexpr bool PERM = true, AFTER_DRAIN = false;
    bf16_t* O; int ldc;
    __device__ __forceinline__ void operator()(const f32x4 (&acc)[2][2][4][2], const Unit& u, int wr, int wc, int fr, int fq) const {
        const int row0 = u.pm * BM + wr * 64 + fr; const int col0 = u.pn * BM + wc * 32 + 8 * fq;
#pragma unroll
        for (int ai = 0; ai < 2; ++ai)
#pragma unroll
            for (int m = 0; m < 4; ++m) { bf16_t* rowp = O + (size_t)(row0 + ai * HALF + m * 16) * ldc + col0;
#pragma unroll
                for (int bj = 0; bj < 2; ++bj) { const f32x4 v0 = acc[ai][bj][m][0], v1 = acc[ai][bj][m][1];
                    u32x4 w; w.x = ::cvtpk(v0[0], v0[1]); w.y = ::cvtpk(v0[2], v0[3]); w.z = ::cvtpk(v1[0], v1[1]); w.w = ::cvtpk(v1[2], v1[3]);
                    *(u32x4*)(rowp + bj * HALF) = w; } }
    }
};
struct EpiResF32 {
    static constexpr bool PERM = false, AFTER_DRAIN = false;
    const float* base; float* C; bf16_t* Xb; float* ssq; int ldc;
    __device__ __forceinline__ void operator()(const f32x4 (&acc)[2][2][4][2], const Unit& u, int wr, int wc, int fr, int fq) const {
        const int row0 = u.pm * BM + wr * 64 + fr, col0 = u.pn * BM + wc * 32 + 4 * fq;
#pragma unroll
        for (int ai = 0; ai < 2; ++ai)
#pragma unroll
            for (int m = 0; m < 4; ++m) { const int row = row0 + ai * HALF + m * 16; const size_t off = (size_t)row * ldc + col0; float s = 0.f;
#pragma unroll
                for (int bj = 0; bj < 2; ++bj)
#pragma unroll
                    for (int n = 0; n < 2; ++n) { const f32x4 b = *(const f32x4*)(base + off + bj * HALF + n * 16); const f32x4 v = acc[ai][bj][m][n] + b; *(f32x4*)(C + off + bj * HALF + n * 16) = v;
                        s += (v[0] * v[0] + v[1] * v[1]) + (v[2] * v[2] + v[3] * v[3]);
                        u32x2 w; w.x = ::cvtpk(v[0], v[1]); w.y = ::cvtpk(v[2], v[3]); *(u32x2*)(Xb + off + bj * HALF + n * 16) = w; }
                s = ::swap16_sum(s, s); s = ::swap32_sum(s, s);
                if (fq == 0) ssq[(size_t)row * 16 + u.pn * 4 + wc] = s; }
    }
};

template <class Epi, class Sched, bool ALIGN_EPI = false, bool SP2 = false>
__device__ __forceinline__ void gemm_phase(PG8_LAS unsigned char* lds, const Gemm g, const Sched& S, const Epi& E) {
    int tid_l = threadIdx.x; asm volatile("" : "+v"(tid_l));
    const int tid = tid_l, wid = __builtin_amdgcn_readfirstlane(tid >> 6), lane = tid & 63, wr = wid >> 2, wc = wid & 3, fr = lane & 15, fq = lane >> 4;
    const int K = g.K, nt = K / BK;
    unsigned voffA[2], voffB[2];
#pragma unroll
    for (int i = 0; i < 2; ++i) { int R, C; stage_rc(tid * 16 + i * 8192, R, C); const int Rb = Epi::PERM ? ((R & ~31) + perm32(R & 31)) : R;
        voffA[i] = (unsigned)(R * K + C) * 2u; voffB[i] = (unsigned)(Rb * K + C) * 2u; }
    const size_t kstep = (size_t)(BK * 2);
    const size_t hstep = (size_t)HALF * K * 2;
    const size_t tstep = 2 * hstep;
    const unsigned ldsw = (unsigned)wid * 1024u;
    const int aoff = lds_byte(wr * 64 + fr, fq * 8), boff = lds_byte(wc * 32 + fr, fq * 8);
#define PG8_SA(b, h) (((b) * 2 + (h)) * HTB)
#define PG8_SB(b, h) ((4 + (b) * 2 + (h)) * HTB)
#define PG8_STAGE(bufoff, gbase, voff) do { _Pragma("unroll") for (int _i = 0; _i < 2; ++_i) \
        __builtin_amdgcn_global_load_lds((const unsigned*)((const char*)(gbase) + (voff)[_i]), (PG8_LAS unsigned*)(lds + (bufoff) + ldsw + _i * 8192), 16, 0, 0); } while (0)
#define PG8_LDA(dst, b, h) do { _Pragma("unroll") for (int m = 0; m < 4; ++m) _Pragma("unroll") for (int k = 0; k < 2; ++k) dst[m][k] = *(const PG8_LAS bf16x8*)(lds + PG8_SA(b, h) + aoff + m * 2048 + k * 1024); } while (0)
#define PG8_LDB(dst, b, h) do { _Pragma("unroll") for (int n = 0; n < 2; ++n) _Pragma("unroll") for (int k = 0; k < 2; ++k) dst[n][k] = *(const PG8_LAS bf16x8*)(lds + PG8_SB(b, h) + boff + n * 2048 + k * 1024); } while (0)
#define PG8_MMA(ai, bj, At, Bt) do { __builtin_amdgcn_s_setprio(1); _Pragma("unroll") for (int m = 0; m < 4; ++m) _Pragma("unroll") for (int n = 0; n < 2; ++n) _Pragma("unroll") for (int k = 0; k < 2; ++k) \
        acc[ai][bj][m][n] = __builtin_amdgcn_mfma_f32_16x16x32_bf16(Bt[n][k], At[m][k], acc[ai][bj][m][n], 0, 0, 0); __builtin_amdgcn_s_setprio(0); } while (0)
#define PG8_WAIT_V(n) asm volatile("s_waitcnt vmcnt(" #n ")" ::: "memory")
#define PG8_WAIT_L(n) asm volatile("s_waitcnt lgkmcnt(" #n ")" ::: "memory")
#define PG8_BAR __builtin_amdgcn_s_barrier()
#define PG8_SCHED __builtin_amdgcn_sched_barrier(0)
    Unit cur, nxt; int ui = 0;
    if (!S.next(0, cur)) return;
    f32x4 acc[2][2][4][2];
#pragma unroll
    for (int a = 0; a < 2; ++a)
#pragma unroll
        for (int b = 0; b < 2; ++b)
#pragma unroll
            for (int m = 0; m < 4; ++m)
#pragma unroll
                for (int n = 0; n < 2; ++n) acc[a][b][m][n] = (f32x4){0.f, 0.f, 0.f, 0.f};
    bf16x8 At[4][2], B0[2][2], B1[2][2];
    const char* cA = (const char*)g.A + (size_t)cur.pm * tstep; const char* cB = (const char*)g.Bt + (size_t)cur.pn * tstep;
    S.a_ready(cur);
    if constexpr (SP2) {
        PG8_STAGE(PG8_SB(0, 0), cB, voffB); PG8_STAGE(PG8_SB(0, 1), cB + hstep, voffB); PG8_STAGE(PG8_SA(0, 0), cA, voffA); PG8_STAGE(PG8_SA(0, 1), cA + hstep, voffA);
        if (wr == 1) PG8_BAR;
        PG8_WAIT_V(2); PG8_BAR;
        PG8_STAGE(PG8_SB(1, 0), cB + kstep, voffB); PG8_STAGE(PG8_SA(1, 0), cA + kstep, voffA); PG8_STAGE(PG8_SB(1, 1), cB + hstep + kstep, voffB);
        PG8_WAIT_V(6); PG8_BAR;
    } else {
        PG8_STAGE(PG8_SB(0, 0), cB, voffB); PG8_STAGE(PG8_SA(0, 0), cA, voffA); PG8_STAGE(PG8_SB(0, 1), cB + hstep, voffB); PG8_STAGE(PG8_SA(0, 1), cA + hstep, voffA);
        if (wr == 1) PG8_BAR;
        PG8_WAIT_V(4); PG8_BAR;
        PG8_STAGE(PG8_SB(1, 0), cB + kstep, voffB); PG8_STAGE(PG8_SA(1, 0), cA + kstep, voffA); PG8_STAGE(PG8_SB(1, 1), cB + hstep + kstep, voffB);
        PG8_WAIT_V(6); PG8_BAR;
    }
    for (;;) {
        const bool has_next = S.next(ui + 1, nxt);
        const char* nA = has_next ? (const char*)g.A + (size_t)nxt.pm * tstep : cA; const char* nB = has_next ? (const char*)g.Bt + (size_t)nxt.pn * tstep : cB;
        for (int t = 0; t < nt; t += 2) {
            const bool last = (t == nt - 2);
            const char* a1 = cA + (size_t)(t + 1) * kstep;
            const char* a2 = last ? nA : cA + (size_t)(t + 2) * kstep; const char* b2 = last ? nB : cB + (size_t)(t + 2) * kstep;
            const char* a3 = a2 + kstep; const char* b3 = b2 + kstep;
            if (last && has_next) S.a_ready(nxt);
            if constexpr (SP2) {
            PG8_LDB(B0, 0, 0); PG8_LDB(B1, 0, 1); PG8_SCHED; PG8_LDA(At, 0, 0); PG8_STAGE(PG8_SA(1, 1), a1 + hstep, voffA);
            PG8_WAIT_V(8); PG8_WAIT_L(0); PG8_BAR; PG8_MMA(0, 0, At, B0); PG8_MMA(0, 1, At, B1); PG8_BAR; PG8_SCHED;
            PG8_LDA(At, 0, 1); PG8_STAGE(PG8_SB(0, 0), b2, voffB); PG8_STAGE(PG8_SB(0, 1), b2 + hstep, voffB); PG8_STAGE(PG8_SA(0, 0), a2, voffA);
            PG8_WAIT_V(8); PG8_WAIT_L(0); PG8_BAR; PG8_MMA(1, 0, At, B0); PG8_MMA(1, 1, At, B1); PG8_BAR; PG8_SCHED;
            PG8_LDB(B0, 1, 0); PG8_LDB(B1, 1, 1); PG8_SCHED; PG8_LDA(At, 1, 0); PG8_STAGE(PG8_SA(0, 1), a2 + hstep, voffA);
            PG8_WAIT_V(8); PG8_WAIT_L(0); PG8_BAR; PG8_MMA(0, 0, At, B0); PG8_MMA(0, 1, At, B1); PG8_BAR; PG8_SCHED;
            PG8_LDA(At, 1, 1); PG8_STAGE(PG8_SB(1, 0), b3, voffB); PG8_STAGE(PG8_SB(1, 1), b3 + hstep, voffB); PG8_STAGE(PG8_SA(1, 0), a3, voffA);
            PG8_WAIT_V(8); PG8_WAIT_L(0); PG8_BAR; PG8_MMA(1, 0, At, B0); PG8_MMA(1, 1, At, B1); PG8_BAR; PG8_SCHED;
            } else {
            PG8_LDB(B0, 0, 0); PG8_SCHED; PG8_LDA(At, 0, 0); PG8_STAGE(PG8_SA(1, 1), a1 + hstep, voffA);
            PG8_WAIT_L(8); PG8_BAR; PG8_WAIT_L(0); PG8_MMA(0, 0, At, B0); PG8_BAR; PG8_SCHED;
            PG8_LDB(B1, 0, 1); PG8_STAGE(PG8_SB(0, 0), b2, voffB);
            PG8_BAR; PG8_WAIT_L(0); PG8_MMA(0, 1, At, B1); PG8_BAR;
            PG8_LDA(At, 0, 1); PG8_STAGE(PG8_SA(0, 0), a2, voffA);
            PG8_BAR; PG8_WAIT_L(0); PG8_MMA(1, 0, At, B0); PG8_BAR; PG8_SCHED;
            PG8_STAGE(PG8_SB(0, 1), b2 + hstep, voffB);
            PG8_WAIT_V(6); PG8_BAR; PG8_MMA(1, 1, At, B1); PG8_BAR;
            PG8_LDB(B0, 1, 0); PG8_SCHED; PG8_LDA(At, 1, 0); PG8_STAGE(PG8_SA(0, 1), a2 + hstep, voffA);
            PG8_WAIT_L(8); PG8_BAR; PG8_WAIT_L(0); PG8_MMA(0, 0, At, B0); PG8_BAR; PG8_SCHED;
            PG8_LDB(B1, 1, 1); PG8_STAGE(PG8_SB(1, 0), b3, voffB);
            PG8_BAR; PG8_WAIT_L(0); PG8_MMA(0, 1, At, B1); PG8_BAR;
            PG8_LDA(At, 1, 1); PG8_STAGE(PG8_SA(1, 0), a3, voffA);
            PG8_BAR; PG8_WAIT_L(0); PG8_MMA(1, 0, At, B0); PG8_BAR; PG8_SCHED;
            PG8_STAGE(PG8_SB(1, 1), b3 + hstep, voffB);
            PG8_WAIT_V(6); PG8_BAR; PG8_MMA(1, 1, At, B1); PG8_BAR;
            }
        }
        if constexpr (ALIGN_EPI) { if (wr == 0) PG8_BAR; }
        if constexpr (!Epi::AFTER_DRAIN) { E(acc, cur, wr, wc, fr, fq); S.done(cur); }
        if (!has_next) break;
#pragma unroll
        for (int a = 0; a < 2; ++a)
#pragma unroll
            for (int b = 0; b < 2; ++b)
#pragma unroll
                for (int m = 0; m < 4; ++m)
#pragma unroll
                    for (int n = 0; n < 2; ++n) acc[a][b][m][n] = (f32x4){0.f, 0.f, 0.f, 0.f};
        cur = nxt; cA = nA; cB = nB; ++ui;
        if constexpr (ALIGN_EPI) { if (wr == 1) PG8_BAR; }
    }
    PG8_WAIT_V(0);
    if constexpr (!ALIGN_EPI) { if (wr == 0) PG8_BAR; }
    PG8_BAR;
    if constexpr (Epi::AFTER_DRAIN) { E.fused(acc, cur, wr, wc, fr, fq, lds, wid, lane); S.done(cur); }
#undef PG8_SA
#undef PG8_SB
#undef PG8_STAGE
#undef PG8_LDA
#undef PG8_LDB
#undef PG8_MMA
#undef PG8_WAIT_V
#undef PG8_WAIT_L
#undef PG8_BAR
#undef PG8_SCHED
}
}

__device__ __forceinline__ int crow(int r, int hi) { return (r & 3) + 8 * (r >> 2) + 4 * hi; }
__device__ __forceinline__ float fmax3(float a, float b, float c) { return fmaxf(fmaxf(a, b), c); }

__device__ __forceinline__ void norm_row_to_bf16(const float* xrow, const float* g, bf16_t* orow, int lane) {
    const f32x4* xr = (const f32x4*)xrow + lane;
    const f32x4* gr = (const f32x4*)g + lane;
    f32x4 v[4]; float s = 0.f;
#pragma unroll
    for (int j = 0; j < 4; ++j) { v[j] = xr[64 * j]; s += (v[j].x * v[j].x + v[j].y * v[j].y) + (v[j].z * v[j].z + v[j].w * v[j].w); }
    const float rs = rsqrtf(wave_sum(s) * (1.0f / DM) + EPS);
    u32x2* o8 = (u32x2*)orow + lane;
#pragma unroll
    for (int j = 0; j < 4; ++j) { const f32x4 gg = gr[64 * j]; u32x2 w; w.x = cvtpk(v[j].x * rs * gg.x, v[j].y * rs * gg.y); w.y = cvtpk(v[j].z * rs * gg.z, v[j].w * rs * gg.w); o8[64 * j] = w; }
}

__device__ __forceinline__ void p0_transpose_item(const float* W, int K, int N, bf16_t* WT, LAS float* scr, int item, int lane, const float* kgain = nullptr) {
    const int nblk = N / 32, kb = item / nblk, nb = item % nblk, k0 = 64 * kb, n0 = 32 * nb;
#pragma unroll 8
    for (int i = 0; i < 32; ++i) { const int kk = 2 * i + (lane >> 5); const float gk = kgain ? kgain[k0 + kk] : 1.0f; scr[kk * 33 + (lane & 31)] = W[(size_t)(k0 + kk) * N + n0 + (lane & 31)] * gk; }
    asm volatile("s_waitcnt lgkmcnt(0)" ::: "memory");
    const int c = lane & 7;
#pragma unroll
    for (int j = 0; j < 4; ++j) { const int n = (lane >> 3) + 8 * j; const LAS float* s = scr + (8 * c) * 33 + n;
        u32x4 o; o.x = cvtpk(s[0 * 33], s[1 * 33]); o.y = cvtpk(s[2 * 33], s[3 * 33]); o.z = cvtpk(s[4 * 33], s[5 * 33]); o.w = cvtpk(s[6 * 33], s[7 * 33]);
        *(u32x4*)(WT + (size_t)(n0 + n) * K + k0 + 8 * c) = o; }
    asm volatile("s_waitcnt lgkmcnt(0)" ::: "memory");
}

struct Ctx {
    LAS unsigned char* lds;
    int tid, lane, wave, vcu, G, gw, NGW;
    const float* const* in; float* out; unsigned char* ws;
};

__device__ __forceinline__ void phase_p0(const Ctx& F) {
    const float* w_in = F.in[2]; const float* w_out = F.in[6]; const float* wq = F.in[8]; const float* keys = F.in[9];
    const float* pu = F.in[10]; const float* pv = F.in[11];
    LAS float* scr = (LAS float*)(F.lds + F.wave * 16384);
    constexpr int I_IN = 16 * 72, I_SQ = 16 * 32, I_L = I_IN + 2 * I_SQ, NIT = 2 * I_L;
    for (int it = F.gw; it < NIT; it += F.NGW) {
        const int l = it / I_L, r = it % I_L;
        if (r < I_IN) p0_transpose_item(w_in + (size_t)l * DM * PW, DM, PW, (bf16_t*)(F.ws + WS_WIN) + (size_t)l * PW * DM, scr, r, F.lane);
        else if (r < I_IN + I_SQ) p0_transpose_item(w_out + (size_t)l * DM * DM, DM, DM, (bf16_t*)(F.ws + WS_WOUT) + (size_t)l * DM * DM, scr, r - I_IN, F.lane);
        else p0_transpose_item(wq + (size_t)l * DM * DM, DM, DM, (bf16_t*)(F.ws + WS_WQ) + (size_t)l * DM * DM, scr, r - I_IN - I_SQ, F.lane, F.in[7] + (size_t)l * DM);
    }
    const int gtid = F.vcu * NTHREADS + F.tid, NT = F.G * NTHREADS;
    for (int i = gtid; i < 262144 / 8; i += NT) {
        const f32x4 a = *(const f32x4*)(keys + (size_t)i * 8), b = *(const f32x4*)(keys + (size_t)i * 8 + 4);
        u32x4 o; o.x = cvtpk(a.x, a.y); o.y = cvtpk(a.z, a.w); o.z = cvtpk(b.x, b.y); o.w = cvtpk(b.z, b.w);
        *(u32x4*)((bf16_t*)(F.ws + WS_KEYS) + (size_t)i * 8) = o;
    }
#pragma unroll 2
    for (int rp = F.gw; rp < 2 * NEXP * 2 / 2; rp += F.NGW) {
        const int row = 2 * rp + (F.lane >> 5), k = F.lane & 31;
        const bool isv = row >= 2 * NEXP; const int rr = isv ? row - 2 * NEXP : row;
        const float* src = (isv ? pv : pu) + (size_t)rr * DM + 4 * k;
        f32x16 a, b;
#pragma unroll
        for (int i = 0; i < 8; ++i) { const f32x4 t = *(const f32x4*)(src + 128 * i); a[2 * i] = t.x; b[2 * i] = t.y; a[2 * i + 1] = t.z; b[2 * i + 1] = t.w; }
        float am = 0.f;
#pragma unroll
        for (int i = 0; i < 16; ++i) am = fmaxf(am, fmaxf(fabsf(a[i]), fabsf(b[i])));
        am = fmaxf(am, dppf<DPP_XOR1>(am)); am = fmaxf(am, dppf<DPP_XOR2>(am)); am = fmaxf(am, dppf<DPP_HMIR>(am)); am = fmaxf(am, dppf<DPP_RMIR>(am)); am = swap16_max(am);
        const float sc = am > 0.f ? exp2f(ceilf(log2f(am * (1.0f / 7.5f)))) : 1.0f, inv = 1.0f / sc;
        a = a * inv; b = b * inv;
        const u32x6 w = __builtin_amdgcn_cvt_scalef32_2xpk16_fp6_f32(a, b, 1.0f);
        *(u32x6_a8*)(F.ws + (isv ? WS_V : WS_U) + (size_t)rr * ROWB + 24 * k) = w;
        if (k == 0) ((float*)(F.ws + (isv ? WS_SV : WS_SU)))[rr] = sc;
    }
    for (int e = gtid; e < 2048 * 64; e += NT) {
        const int pos = e >> 6, i = e & 63;
        float ang;
        if (i < 32) ang = (float)pos * powf(10000.0f, -(float)i / 32.0f);
        else if (i < 48) ang = (float)(pos >> 6) * powf(10000.0f, -(float)(i - 32) / 16.0f);
        else ang = (float)(pos & 63) * powf(10000.0f, -(float)(i - 48) / 16.0f);
        f32x2_t cs; cs.x = cosf(ang); cs.y = sinf(ang);
        ((f32x2_t*)(F.ws + WS_ROPE))[e] = cs;
    }
    for (int m = F.gw; m < MTOK; m += 2 * F.NGW) {
        const int m2 = m + F.NGW;
        const f32x4* xa = (const f32x4*)(F.in[0] + (size_t)m * DM) + F.lane; const f32x4* xb = (const f32x4*)(F.in[0] + (size_t)(m2 < MTOK ? m2 : m) * DM) + F.lane;
        const f32x4* gr = (const f32x4*)F.in[1] + F.lane;
        f32x4 va[4], vb[4]; float sa = 0.f, sb = 0.f;
#pragma unroll
        for (int j = 0; j < 4; ++j) { va[j] = xa[64 * j]; vb[j] = xb[64 * j]; }
#pragma unroll
        for (int j = 0; j < 4; ++j) { sa += (va[j].x * va[j].x + va[j].y * va[j].y) + (va[j].z * va[j].z + va[j].w * va[j].w); sb += (vb[j].x * vb[j].x + vb[j].y * vb[j].y) + (vb[j].z * vb[j].z + vb[j].w * vb[j].w); }
        const float ra = rsqrtf(wave_sum(sa) * (1.0f / DM) + EPS), rb = rsqrtf(wave_sum(sb) * (1.0f / DM) + EPS);
        u32x2* oa = (u32x2*)((bf16_t*)(F.ws + WS_H) + (size_t)m * DM) + F.lane; u32x2* ob = (u32x2*)((bf16_t*)(F.ws + WS_H) + (size_t)(m2 < MTOK ? m2 : m) * DM) + F.lane;
#pragma unroll
        for (int j = 0; j < 4; ++j) { const f32x4 gg = gr[64 * j];
            u32x2 w; w.x = cvtpk(va[j].x * ra * gg.x, va[j].y * ra * gg.y); w.y = cvtpk(va[j].z * ra * gg.z, va[j].w * ra * gg.w); oa[64 * j] = w;
            if (m2 < MTOK) { u32x2 v; v.x = cvtpk(vb[j].x * rb * gg.x, vb[j].y * rb * gg.y); v.y = cvtpk(vb[j].z * rb * gg.z, vb[j].w * rb * gg.w); ob[64 * j] = v; } }
    }
}

__device__ __forceinline__ void phase_norm(const Ctx& F, const float* x, const float* g) {
    for (int m = F.gw; m < MTOK; m += F.NGW) norm_row_to_bf16(x + (size_t)m * DM, g, (bf16_t*)(F.ws + WS_H) + (size_t)m * DM, F.lane);
}

__device__ __forceinline__ void head_info(int hs, int& type, int& gi) {
    if (hs < 6) { type = 1; gi = 0; } else if (hs < 8) { type = 1; gi = 1; } else if (hs < 10) { type = 0; gi = 0; }
    else if (hs < 16) { type = 2; gi = 2; } else if (hs < 22) { type = 2; gi = 3; } else if (hs < 28) { type = 0; gi = 0; }
    else if (hs < 32) { type = 2; gi = 4; } else if (hs < 34) { type = 2; gi = 5; } else { type = 0; gi = 0; }
}
__device__ __forceinline__ void phase_rope(const Ctx& F, const float* gain  ) {
    bf16_t* P = (bf16_t*)(F.ws + WS_P);
    const f32x2_t* tab = (const f32x2_t*)(F.ws + WS_ROPE);
    const int s = F.lane & 7, grp8 = F.lane >> 3;
#pragma unroll 2
    for (int tok = F.gw; tok < MTOK; tok += F.NGW) {
        const int pos = tok & (SEQ - 1);
        bf16_t* row = P + (size_t)tok * PW;
#pragma unroll 1
        for (int pass = 0; pass < 2; ++pass) {
            const int hs = pass == 0 ? (grp8 < 2 ? 6 + grp8 : 14 + grp8) : (grp8 < 2 ? 32 + grp8 : 33);
            const bool act = pass == 0 || grp8 < 2;
            int type, gi; head_info(hs, type, gi);
            const u32x4 raw = *(const u32x4*)(row + hs * 64 + s * 8);
            float x[8]; x[0] = bf_lo(raw.x); x[1] = bf_hi(raw.x); x[2] = bf_lo(raw.y); x[3] = bf_hi(raw.y); x[4] = bf_lo(raw.z); x[5] = bf_hi(raw.z); x[6] = bf_lo(raw.w); x[7] = bf_hi(raw.w);
            float ss = 0.f;
#pragma unroll
            for (int e = 0; e < 8; ++e) ss += x[e] * x[e];
            ss += dppf<DPP_XOR1>(ss); ss += dppf<DPP_XOR2>(ss); ss += dppf<DPP_HMIR>(ss);
            const float rs = rsqrtf(ss * (1.0f / 64.0f) + EPS);
            const f32x4 g0 = *(const f32x4*)(gain + gi * 64 + s * 8), g1 = *(const f32x4*)(gain + gi * 64 + s * 8 + 4);
            float y[8]; y[0] = x[0] * rs * g0.x; y[1] = x[1] * rs * g0.y; y[2] = x[2] * rs * g0.z; y[3] = x[3] * rs * g0.w; y[4] = x[4] * rs * g1.x; y[5] = x[5] * rs * g1.y; y[6] = x[6] * rs * g1.z; y[7] = x[7] * rs * g1.w;
            const bool one_d = (type == 2);
            const int tbase = one_d ? 8 * (s & 3) : 32 + (s >> 2) * 16 + 8 * (s & 1);
            const bool isx1 = one_d ? (s < 4) : ((s & 2) == 0);
            float o[8];
#pragma unroll
            for (int e = 0; e < 8; ++e) {
                const float o4 = dppf<DPP_HMIR>(dppf<DPP_XOR3>(y[e])), o2 = dppf<DPP_XOR2>(y[e]);
                const float oth = one_d ? o4 : o2;
                const f32x2_t cs = tab[pos * 64 + tbase + e];
                o[e] = isx1 ? (y[e] * cs.x - oth * cs.y) : (oth * cs.y + y[e] * cs.x);
            }
            if (act) {
                u32x4 w; w.x = cvtpk(o[0], o[1]); w.y = cvtpk(o[2], o[3]); w.z = cvtpk(o[4], o[5]); w.w = cvtpk(o[6], o[7]);
                *(u32x4*)(row + hs * 64 + s * 8) = w;
            }
        }
    }
}

struct AUnit {
    const bf16_t* q; const bf16_t* k; const bf16_t* v;
    bf16_t* o; float* lse;
    int ostride, btok, r, c, pair, pos0, T0, T1, W, has_sink; float sink2;
    const float* qgain; const f32x2_t* ropetab; int qaxial;
};
constexpr int ATT_KV = 0, ATT_WSF = 32768, ATT_OST = 34816;

__device__ __forceinline__ void attn_unit(const AUnit& U, LAS unsigned char* lds, int tid) {
    const int lane = tid & 63, r32 = lane & 31, hi = lane >> 5; const int wid = __builtin_amdgcn_readfirstlane(tid >> 6);
    const int sub = U.pair ? (wid >> 2) : 0;
    const int ipos0 = U.pair ? 32 * (wid & 3) : U.pos0 + 32 * wid;
    const int myi = ipos0 + r32;
    const int tokq0 = U.btok + U.c + sub;
    int wt0, wt1;
    if (U.pair) { wt0 = 2 * sub; wt1 = wt0 + 2; }
    else if (U.W >= 0) { wt0 = max(U.T0, (ipos0 - U.W) >> 6); wt1 = min(U.T1, ((ipos0 + 31 + U.W) >> 6) + 1); }
    else { wt0 = U.T0; wt1 = U.T1; }
    const int vkey = 16 * (wid & 3) + (lane >> 2);
    const int kcol = wid * 8, vcol = (wid >> 2) * 32 + (lane & 3) * 8;
    const unsigned stoff = (unsigned)wid * 1024u + (unsigned)lane * 16u;
#define ATT_TOK(t, key) (U.pair ? (U.btok + U.c + ((t) >> 1) + (64 * ((t) & 1) + (key)) * 16) : (U.btok + U.c + (64 * (t) + (key)) * U.r))
    LAS float* wsf = (LAS float*)(lds + ATT_WSF) + wid * 64;
    float m = U.has_sink ? U.sink2 : 0.f;
    bool started = U.has_sink != 0;
    f32x16 negm;
#pragma unroll
    for (int r = 0; r < 16; ++r) negm[r] = -m;
    float l = (U.has_sink && hi == 0) ? 1.0f : 0.0f;
    f32x16 o0 = {}, o1 = {};
    u32x4 kA, vA, kB, vB;
#define ATT_LD(KR, VR, tt) do { const int t__ = min((tt), U.T1 - 1); KR = *(const u32x4*)(U.k + (size_t)ATT_TOK(t__, lane) * PW + kcol); VR = *(const u32x4*)(U.v + (size_t)ATT_TOK(t__, vkey) * PW + vcol); } while (0)
#define ATT_ST(bufi, KR, VR) do { *(LAS u32x4*)(lds + ATT_KV + (bufi) * 16384 + stoff) = KR; *(LAS u32x4*)(lds + ATT_KV + (bufi) * 16384 + 8192 + stoff) = VR; } while (0)
    ATT_LD(kA, vA, U.T0);
    bf16x8 qr[4];
    {   const int qtok = tokq0 + myi * U.r, pos = qtok & (SEQ - 1);
        const bf16_t* qp = U.q + (size_t)qtok * PW + hi * 8;
        float y[4][8]; float ss = 0.f;
#pragma unroll
        for (int d0 = 0; d0 < 4; ++d0) { const u32x4 raw = *(const u32x4*)(qp + d0 * 16);
            y[d0][0] = bf_lo(raw.x); y[d0][1] = bf_hi(raw.x); y[d0][2] = bf_lo(raw.y); y[d0][3] = bf_hi(raw.y); y[d0][4] = bf_lo(raw.z); y[d0][5] = bf_hi(raw.z); y[d0][6] = bf_lo(raw.w); y[d0][7] = bf_hi(raw.w);
#pragma unroll
            for (int j = 0; j < 8; ++j) ss += y[d0][j] * y[d0][j]; }
        ss = swap32_sum(ss, ss);
        const float rs = rsqrtf(ss * (1.0f / 64.0f) + EPS);
#pragma unroll
        for (int d0 = 0; d0 < 4; ++d0) { const f32x4 g0 = *(const f32x4*)(U.qgain + d0 * 16 + hi * 8), g1 = *(const f32x4*)(U.qgain + d0 * 16 + hi * 8 + 4);
            y[d0][0] *= rs * g0.x; y[d0][1] *= rs * g0.y; y[d0][2] *= rs * g0.z; y[d0][3] *= rs * g0.w; y[d0][4] *= rs * g1.x; y[d0][5] *= rs * g1.y; y[d0][6] *= rs * g1.z; y[d0][7] *= rs * g1.w; }
        const f32x2_t* tab = U.ropetab + (size_t)pos * 64;
        float z[4][8];
        if (U.qaxial) {
#pragma unroll
            for (int hf2 = 0; hf2 < 2; ++hf2)
#pragma unroll
                for (int j = 0; j < 8; ++j) { const f32x2_t cs = tab[32 + hf2 * 16 + 8 * hi + j]; const float x1 = y[2 * hf2][j], x2 = y[2 * hf2 + 1][j];
                    z[2 * hf2][j] = x1 * cs.x - x2 * cs.y; z[2 * hf2 + 1][j] = x1 * cs.y + x2 * cs.x; }
        } else {
#pragma unroll
            for (int d0 = 0; d0 < 2; ++d0)
#pragma unroll
                for (int j = 0; j < 8; ++j) { const f32x2_t cs = tab[16 * d0 + 8 * hi + j]; const float x1 = y[d0][j], x2 = y[d0 + 2][j];
                    z[d0][j] = x1 * cs.x - x2 * cs.y; z[d0 + 2][j] = x1 * cs.y + x2 * cs.x; }
        }
#pragma unroll
        for (int d0 = 0; d0 < 4; ++d0) { u32x4 w; w.x = cvtpk(z[d0][0] * QSCALE, z[d0][1] * QSCALE); w.y = cvtpk(z[d0][2] * QSCALE, z[d0][3] * QSCALE); w.z = cvtpk(z[d0][4] * QSCALE, z[d0][5] * QSCALE); w.w = cvtpk(z[d0][6] * QSCALE, z[d0][7] * QSCALE);
            qr[d0] = __builtin_bit_cast(bf16x8, w); }
    }
    ATT_ST(0, kA, vA);
    __syncthreads();
    ATT_LD(kA, vA, U.T0 + 1);
    for (int t = U.T0; t < U.T1; t += 2) {
        ATT_LD(kB, vB, t + 2);
        { const int TT = t; constexpr int CUR = 0;
        if (TT >= wt0 && TT < wt1) {
            LAS const unsigned char* kb = lds + ATT_KV + CUR * 16384 + hi * 1024 + r32 * 16;
            LAS const unsigned char* vp = lds + ATT_KV + CUR * 16384 + 8192 + ((lane >> 4) & 1) * 32 + (lane & 3) * 8 + (4 * hi + ((lane & 15) >> 2)) * 64;
            bf16x8 kf[8];
#pragma unroll
            for (int d0 = 0; d0 < 4; ++d0) { kf[2 * d0] = *(LAS const bf16x8*)(kb + d0 * 2048); kf[2 * d0 + 1] = *(LAS const bf16x8*)(kb + d0 * 2048 + 512); }
            s16x4 vlo[8], vhi[8];
#define ATT_TR(off) __builtin_bit_cast(s16x4, __builtin_amdgcn_ds_read_tr16_b64_v4i16((LAS s16x4*)(vp + (off))))
#pragma unroll
            for (int i = 0; i < 8; ++i) { vlo[i] = ATT_TR((i >> 2) * 4096 + (i & 3) * 1024); vhi[i] = ATT_TR((i >> 2) * 4096 + (i & 3) * 1024 + 512); }
#undef ATT_TR
            f32x16 p0 = negm, p1 = negm;
#pragma unroll
            for (int d0 = 0; d0 < 4; ++d0) {
                p0 = __builtin_amdgcn_mfma_f32_32x32x16_bf16(kf[2 * d0], qr[d0], p0, 0, 0, 0);
                p1 = __builtin_amdgcn_mfma_f32_32x32x16_bf16(kf[2 * d0 + 1], qr[d0], p1, 0, 0, 0);
            }
            if (U.W >= 0) {
                const int jb = (U.pair ? 64 * (TT & 1) : 64 * TT) + 4 * hi;
                const int lo = myi - U.W - jb; const unsigned span = 2u * (unsigned)U.W;
#pragma unroll
                for (int r = 0; r < 16; ++r) {
                    const int jr = (r & 3) + 8 * (r >> 2);
                    if ((unsigned)(jr - lo) > span) p0[r] = -INFINITY;
                    if ((unsigned)(jr + 32 - lo) > span) p1[r] = -INFINITY;
                }
            }
            float mx = fmaxf(p0[0], p1[0]);
#pragma unroll
            for (int r = 1; r < 16; ++r) mx = fmax3(mx, p0[r], p1[r]);
            { auto rr = __builtin_amdgcn_permlane32_swap(__float_as_uint(mx), __float_as_uint(mx), false, false); mx = fmaxf(__uint_as_float(rr[0]), __uint_as_float(rr[1])); }
            if (!started || __any(mx > 8.0f)) {
                float dl = started ? fmaxf(mx, 0.f) : mx;
                if (dl == -INFINITY) dl = 0.f;
                m += dl;
#pragma unroll
                for (int r = 0; r < 16; ++r) { p0[r] -= dl; p1[r] -= dl; negm[r] = -m; }
                if (started) {
                    const float alpha = __builtin_amdgcn_exp2f(-dl);
                    l *= alpha;
                    if (hi == 0) wsf[r32] = alpha;
#pragma unroll
                    for (int r = 0; r < 16; ++r) { const float a = wsf[crow(r, hi)]; o0[r] *= a; o1[r] *= a; }
                }
                started = true;
            }
            float rsum = 0.f;
#pragma unroll
            for (int r = 0; r < 16; ++r) { p0[r] = __builtin_amdgcn_exp2f(p0[r]); p1[r] = __builtin_amdgcn_exp2f(p1[r]); rsum += p0[r] + p1[r]; }
            l += rsum;
            u32x4 pw0, pw1, pw2, pw3;
            pw0.x = cvtpk(p0[0], p0[1]); pw0.y = cvtpk(p0[2], p0[3]); pw0.z = cvtpk(p0[4], p0[5]); pw0.w = cvtpk(p0[6], p0[7]);
            pw1.x = cvtpk(p0[8], p0[9]); pw1.y = cvtpk(p0[10], p0[11]); pw1.z = cvtpk(p0[12], p0[13]); pw1.w = cvtpk(p0[14], p0[15]);
            pw2.x = cvtpk(p1[0], p1[1]); pw2.y = cvtpk(p1[2], p1[3]); pw2.z = cvtpk(p1[4], p1[5]); pw2.w = cvtpk(p1[6], p1[7]);
            pw3.x = cvtpk(p1[8], p1[9]); pw3.y = cvtpk(p1[10], p1[11]); pw3.z = cvtpk(p1[12], p1[13]); pw3.w = cvtpk(p1[14], p1[15]);
#define ATT_VF(i) (bf16x8){vlo[i][0], vlo[i][1], vlo[i][2], vlo[i][3], vhi[i][0], vhi[i][1], vhi[i][2], vhi[i][3]}
            o0 = __builtin_amdgcn_mfma_f32_32x32x16_bf16(__builtin_bit_cast(bf16x8, pw0), ATT_VF(0), o0, 0, 0, 0);
            o1 = __builtin_amdgcn_mfma_f32_32x32x16_bf16(__builtin_bit_cast(bf16x8, pw0), ATT_VF(4), o1, 0, 0, 0);
            o0 = __builtin_amdgcn_mfma_f32_32x32x16_bf16(__builtin_bit_cast(bf16x8, pw1), ATT_VF(1), o0, 0, 0, 0);
            o1 = __builtin_amdgcn_mfma_f32_32x32x16_bf16(__builtin_bit_cast(bf16x8, pw1), ATT_VF(5), o1, 0, 0, 0);
            o0 = __builtin_amdgcn_mfma_f32_32x32x16_bf16(__builtin_bit_cast(bf16x8, pw2), ATT_VF(2), o0, 0, 0, 0);
            o1 = __builtin_amdgcn_mfma_f32_32x32x16_bf16(__builtin_bit_cast(bf16x8, pw2), ATT_VF(6), o1, 0, 0, 0);
            o0 = __builtin_amdgcn_mfma_f32_32x32x16_bf16(__builtin_bit_cast(bf16x8, pw3), ATT_VF(3), o0, 0, 0, 0);
            o1 = __builtin_amdgcn_mfma_f32_32x32x16_bf16(__builtin_bit_cast(bf16x8, pw3), ATT_VF(7), o1, 0, 0, 0);
#undef ATT_VF
        }
        }
        if (t + 1 < U.T1) ATT_ST(1, kA, vA);
        __syncthreads();
        if (t + 1 >= U.T1) break;
        ATT_LD(kA, vA, t + 3);
        { const int TT = t + 1; constexpr int CUR = 1;
        if (TT >= wt0 && TT < wt1) {
            LAS const unsigned char* kb = lds + ATT_KV + CUR * 16384 + hi * 1024 + r32 * 16;
            LAS const unsigned char* vp = lds + ATT_KV + CUR * 16384 + 8192 + ((lane >> 4) & 1) * 32 + (lane & 3) * 8 + (4 * hi + ((lane & 15) >> 2)) * 64;
            bf16x8 kf[8];
#pragma unroll
            for (int d0 = 0; d0 < 4; ++d0) { kf[2 * d0] = *(LAS const bf16x8*)(kb + d0 * 2048); kf[2 * d0 + 1] = *(LAS const bf16x8*)(kb + d0 * 2048 + 512); }
            s16x4 vlo[8], vhi[8];
#define ATT_TR(off) __builtin_bit_cast(s16x4, __builtin_amdgcn_ds_read_tr16_b64_v4i16((LAS s16x4*)(vp + (off))))
#pragma unroll
            for (int i = 0; i < 8; ++i) { vlo[i] = ATT_TR((i >> 2) * 4096 + (i & 3) * 1024); vhi[i] = ATT_TR((i >> 2) * 4096 + (i & 3) * 1024 + 512); }
#undef ATT_TR
            f32x16 p0 = negm, p1 = negm;
#pragma unroll
            for (int d0 = 0; d0 < 4; ++d0) {
                p0 = __builtin_amdgcn_mfma_f32_32x32x16_bf16(kf[2 * d0], qr[d0], p0, 0, 0, 0);
                p1 = __builtin_amdgcn_mfma_f32_32x32x16_bf16(kf[2 * d0 + 1], qr[d0], p1, 0, 0, 0);
            }
            if (U.W >= 0) {
                const int jb = (U.pair ? 64 * (TT & 1) : 64 * TT) + 4 * hi;
                const int lo = myi - U.W - jb; const unsigned span = 2u * (unsigned)U.W;
#pragma unroll
                for (int r = 0; r < 16; ++r) {
                    const int jr = (r & 3) + 8 * (r >> 2);
                    if ((unsigned)(jr - lo) > span) p0[r] = -INFINITY;
                    if ((unsigned)(jr + 32 - lo) > span) p1[r] = -INFINITY;
                }
            }
            float mx = fmaxf(p0[0], p1[0]);
#pragma unroll
            for (int r = 1; r < 16; ++r) mx = fmax3(mx, p0[r], p1[r]);
            { auto rr = __builtin_amdgcn_permlane32_swap(__float_as_uint(mx), __float_as_uint(mx), false, false); mx = fmaxf(__uint_as_float(rr[0]), __uint_as_float(rr[1])); }
            if (!started || __any(mx > 8.0f)) {
                float dl = started ? fmaxf(mx, 0.f) : mx;
                if (dl == -INFINITY) dl = 0.f;
                m += dl;
#pragma unroll
                for (int r = 0; r < 16; ++r) { p0[r] -= dl; p1[r] -= dl; negm[r] = -m; }
                if (started) {
                    const float alpha = __builtin_amdgcn_exp2f(-dl);
                    l *= alpha;
                    if (hi == 0) wsf[r32] = alpha;
#pragma unroll
                    for (int r = 0; r < 16; ++r) { const float a = wsf[crow(r, hi)]; o0[r] *= a; o1[r] *= a; }
                }
                started = true;
            }
            float rsum = 0.f;
#pragma unroll
            for (int r = 0; r < 16; ++r) { p0[r] = __builtin_amdgcn_exp2f(p0[r]); p1[r] = __builtin_amdgcn_exp2f(p1[r]); rsum += p0[r] + p1[r]; }
            l += rsum;
            u32x4 pw0, pw1, pw2, pw3;
            pw0.x = cvtpk(p0[0], p0[1]); pw0.y = cvtpk(p0[2], p0[3]); pw0.z = cvtpk(p0[4], p0[5]); pw0.w = cvtpk(p0[6], p0[7]);
            pw1.x = cvtpk(p0[8], p0[9]); pw1.y = cvtpk(p0[10], p0[11]); pw1.z = cvtpk(p0[12], p0[13]); pw1.w = cvtpk(p0[14], p0[15]);
            pw2.x = cvtpk(p1[0], p1[1]); pw2.y = cvtpk(p1[2], p1[3]); pw2.z = cvtpk(p1[4], p1[5]); pw2.w = cvtpk(p1[6], p1[7]);
            pw3.x = cvtpk(p1[8], p1[9]); pw3.y = cvtpk(p1[10], p1[11]); pw3.z = cvtpk(p1[12], p1[13]); pw3.w = cvtpk(p1[14], p1[15]);
#define ATT_VF(i) (bf16x8){vlo[i][0], vlo[i][1], vlo[i][2], vlo[i][3], vhi[i][0], vhi[i][1], vhi[i][2], vhi[i][3]}
            o0 = __builtin_amdgcn_mfma_f32_32x32x16_bf16(__builtin_bit_cast(bf16x8, pw0), ATT_VF(0), o0, 0, 0, 0);
            o1 = __builtin_amdgcn_mfma_f32_32x32x16_bf16(__builtin_bit_cast(bf16x8, pw0), ATT_VF(4), o1, 0, 0, 0);
            o0 = __builtin_amdgcn_mfma_f32_32x32x16_bf16(__builtin_bit_cast(bf16x8, pw1), ATT_VF(1), o0, 0, 0, 0);
            o1 = __builtin_amdgcn_mfma_f32_32x32x16_bf16(__builtin_bit_cast(bf16x8, pw1), ATT_VF(5), o1, 0, 0, 0);
            o0 = __builtin_amdgcn_mfma_f32_32x32x16_bf16(__builtin_bit_cast(bf16x8, pw2), ATT_VF(2), o0, 0, 0, 0);
            o1 = __builtin_amdgcn_mfma_f32_32x32x16_bf16(__builtin_bit_cast(bf16x8, pw2), ATT_VF(6), o1, 0, 0, 0);
            o0 = __builtin_amdgcn_mfma_f32_32x32x16_bf16(__builtin_bit_cast(bf16x8, pw3), ATT_VF(3), o0, 0, 0, 0);
            o1 = __builtin_amdgcn_mfma_f32_32x32x16_bf16(__builtin_bit_cast(bf16x8, pw3), ATT_VF(7), o1, 0, 0, 0);
#undef ATT_VF
        }
        }
        if (t + 2 < U.T1) ATT_ST(0, kB, vB);
        __syncthreads();
    }
#undef ATT_LD
#undef ATT_ST
#undef ATT_TOK
    float ltot;
    { auto rr = __builtin_amdgcn_permlane32_swap(__float_as_uint(l), __float_as_uint(l), false, false); ltot = __uint_as_float(rr[0]) + __uint_as_float(rr[1]); }
    if (hi == 0) wsf[r32] = 1.0f / ltot;
    LAS bf16_t* stg = (LAS bf16_t*)(lds + ATT_OST) + wid * 2048;
#pragma unroll
    for (int r = 0; r < 16; ++r) {
        const int orow = crow(r, hi); const float rl = wsf[orow];
        stg[orow * 64 + r32] = (bf16_t)(cvtpk(o0[r] * rl, 0.f) & 0xffffu);
        stg[orow * 64 + 32 + r32] = (bf16_t)(cvtpk(o1[r] * rl, 0.f) & 0xffffu);
    }
#pragma unroll
    for (int i = 0; i < 4; ++i) {
        const int row = i * 8 + (lane >> 3), ch = lane & 7;
        const u32x4 v = *(LAS const u32x4*)(stg + row * 64 + ch * 8);
        *(u32x4*)(U.o + (size_t)(tokq0 + (ipos0 + row) * U.r) * U.ostride + ch * 8) = v;
    }
    if (U.lse != nullptr && hi == 0) U.lse[(size_t)(tokq0 + myi * U.r) * 6] = m + __builtin_amdgcn_logf(ltot);
}

__device__ __forceinline__ void phase_attn(const Ctx& F, const float* sink  , const float* gain  ) {
    const bf16_t* P = (const bf16_t*)(F.ws + WS_P);
    bf16_t* MIX = (bf16_t*)(F.ws + WS_MIX); bf16_t* OB = (bf16_t*)(F.ws + WS_OB); float* LSE = (float*)(F.ws + WS_LSE);
    constexpr int NU = 768 * 4 + 512;
    for (int u = F.vcu; u < NU; u += F.G) {
        AUnit U; U.lse = nullptr; U.r = 1; U.c = 0; U.pair = 0; U.W = -1; U.has_sink = 0; U.sink2 = 0.f; U.ropetab = (const f32x2_t*)(F.ws + WS_ROPE);
        if (u < 768) {
            const int b = u / 48, h = (u >> 3) % 6, qb = u & 7;
            U.q = P + C_QA + h * 64; U.k = P + C_KA + (h / 3) * 64; U.v = P + C_VA + (h / 3) * 64; U.o = MIX + h * 64; U.ostride = DM;
            U.btok = b * SEQ; U.pos0 = 256 * qb; U.T0 = 0; U.T1 = 32; U.qgain = gain; U.qaxial = 1;
        } else if (u < 3072) {
            const int br = (u - 768) / 768, uu = (u - 768) % 768;
            const int b = uu / 48, h = (uu >> 3) % 6, x = uu & 7;
            U.q = P + C_QB + h * 64; U.k = P + C_KB + h * 64; U.v = P + C_VB + h * 64; U.o = OB + (size_t)br * MTOK * 384 + h * 64; U.ostride = 384;
            U.lse = LSE + (size_t)br * MTOK * 6 + h; U.btok = b * SEQ; U.W = 64; U.qgain = gain + 2 * 64; U.qaxial = 0;
            if (br == 0) { U.pos0 = 256 * x; U.T0 = max(0, 4 * x - 1); U.T1 = min(32, 4 * x + 5); }
            else if (br == 1) { const int qb = x & 1; U.r = 4; U.c = x >> 1; U.pos0 = 256 * qb; U.T0 = max(0, 4 * qb - 1); U.T1 = min(8, 4 * qb + 5); }
            else { U.r = 16; U.c = 2 * x; U.pair = 1; U.pos0 = 0; U.T0 = 0; U.T1 = 4; }
        } else {
            const int uu = u - 3072; const int b = uu / 32, h = (uu >> 3) & 3, qb = uu & 7;
            U.q = P + C_QC + h * 64; U.k = P + C_KC + (h >> 1) * 64; U.v = P + C_VC + (h >> 1) * 64; U.o = MIX + 768 + h * 64; U.ostride = DM;
            U.btok = b * SEQ; U.pos0 = 256 * qb; U.W = 128; U.T0 = max(0, 4 * qb - 2); U.T1 = min(32, 4 * qb + 6);
            U.has_sink = 1; U.sink2 = sink[h] * LOG2E; U.qgain = gain + 4 * 64; U.qaxial = 0;
        }
        attn_unit(U, F.lds, F.tid);
    }
}

__device__ __forceinline__ void unpack8(const u32x4 w, float (&x)[8]) { x[0] = bf_lo(w.x); x[1] = bf_hi(w.x); x[2] = bf_lo(w.y); x[3] = bf_hi(w.y); x[4] = bf_lo(w.z); x[5] = bf_hi(w.z); x[6] = bf_lo(w.w); x[7] = bf_hi(w.w); }
__device__ __forceinline__ void phase_post(const Ctx& F, const float* g  ) {
    const bf16_t* MIX = (const bf16_t*)(F.ws + WS_MIX); const bf16_t* OB = (const bf16_t*)(F.ws + WS_OB); const float* LSE = (const float*)(F.ws + WS_LSE);
    bf16_t* H = (bf16_t*)(F.ws + WS_H);
    const int lane = F.lane; const int l48 = lane < 48 ? lane : 47, l32 = lane < 32 ? lane : 31;
#pragma unroll 2
    for (int tok = F.gw; tok < MTOK; tok += F.NGW) {
        float a[8], bsum[8], c[8];
        unpack8(*(const u32x4*)(MIX + (size_t)tok * DM + l48 * 8), a);
        unpack8(*(const u32x4*)(MIX + (size_t)tok * DM + 768 + l32 * 8), c);
        const int h = l48 >> 3;
        const float ls0 = LSE[(size_t)tok * 6 + h], ls1 = LSE[(size_t)(MTOK + tok) * 6 + h], ls2 = LSE[(size_t)(2 * MTOK + tok) * 6 + h];
        const float mxl = fmax3(ls0, ls1, ls2);
        float w0 = __builtin_amdgcn_exp2f(ls0 - mxl), w1 = __builtin_amdgcn_exp2f(ls1 - mxl), w2 = __builtin_amdgcn_exp2f(ls2 - mxl);
        const float inv = 1.0f / (w0 + w1 + w2); w0 *= inv; w1 *= inv; w2 *= inv;
        { float t0[8], t1[8], t2[8];
          unpack8(*(const u32x4*)(OB + (size_t)tok * 384 + l48 * 8), t0);
          unpack8(*(const u32x4*)(OB + (size_t)(MTOK + tok) * 384 + l48 * 8), t1);
          unpack8(*(const u32x4*)(OB + (size_t)(2 * MTOK + tok) * 384 + l48 * 8), t2);
#pragma unroll
          for (int e = 0; e < 8; ++e) bsum[e] = w0 * t0[e] + w1 * t1[e] + w2 * t2[e]; }
        float sa = 0.f, sb = 0.f, sc = 0.f;
#pragma unroll
        for (int e = 0; e < 8; ++e) { sa += a[e] * a[e]; sb += bsum[e] * bsum[e]; sc += c[e] * c[e]; }
        if (lane >= 48) { sa = 0.f; sb = 0.f; }
        if (lane >= 32) sc = 0.f;
        sa = wave_sum(sa); sb = wave_sum(sb); sc = wave_sum(sc);
        const float ra = rsqrtf(sa * (1.0f / 384.0f) + EPS), rb = rsqrtf(sb * (1.0f / 384.0f) + EPS), rc = rsqrtf(sc * (1.0f / 256.0f) + EPS);
        if (lane < 48) {
            const f32x4 g0 = *(const f32x4*)(g + lane * 8), g1 = *(const f32x4*)(g + lane * 8 + 4);
            u32x4 w; w.x = cvtpk(a[0] * ra * g0.x, a[1] * ra * g0.y); w.y = cvtpk(a[2] * ra * g0.z, a[3] * ra * g0.w); w.z = cvtpk(a[4] * ra * g1.x, a[5] * ra * g1.y); w.w = cvtpk(a[6] * ra * g1.z, a[7] * ra * g1.w);
            *(u32x4*)(H + (size_t)tok * DM + lane * 8) = w;
            const f32x4 h0 = *(const f32x4*)(g + 384 + lane * 8), h1 = *(const f32x4*)(g + 384 + lane * 8 + 4);
            u32x4 v; v.x = cvtpk(bsum[0] * rb * h0.x, bsum[1] * rb * h0.y); v.y = cvtpk(bsum[2] * rb * h0.z, bsum[3] * rb * h0.w); v.z = cvtpk(bsum[4] * rb * h1.x, bsum[5] * rb * h1.y); v.w = cvtpk(bsum[6] * rb * h1.z, bsum[7] * rb * h1.w);
            *(u32x4*)(H + (size_t)tok * DM + 384 + lane * 8) = v;
        }
        if (lane < 32) {
            const f32x4 g0 = *(const f32x4*)(g + 768 + lane * 8), g1 = *(const f32x4*)(g + 768 + lane * 8 + 4);
            u32x4 w; w.x = cvtpk(c[0] * rc * g0.x, c[1] * rc * g0.y); w.y = cvtpk(c[2] * rc * g0.z, c[3] * rc * g0.w); w.z = cvtpk(c[4] * rc * g1.x, c[5] * rc * g1.y); w.w = cvtpk(c[6] * rc * g1.z, c[7] * rc * g1.w);
            *(u32x4*)(H + (size_t)tok * DM + 768 + lane * 8) = w;
        }
    }
}

__device__ __forceinline__ float vmaxr(float a, float b) { float r; asm("v_max_f32_e32 %0, %1, %2" : "=v"(r) : "v"(a), "v"(b)); return r; }
__device__ __forceinline__ float vminr(float a, float b) { float r; asm("v_min_f32_e32 %0, %1, %2" : "=v"(r) : "v"(a), "v"(b)); return r; }
#define CEX_D(a, b) do { const float hi_ = vmaxr(a, b), lo_ = vminr(a, b); a = hi_; b = lo_; } while (0)
template <int N> __device__ __forceinline__ void bitonic_sort_desc(float (&v)[N]) {
#pragma unroll
    for (int k = 2; k <= N; k <<= 1)
#pragma unroll
        for (int j = k >> 1; j > 0; j >>= 1)
#pragma unroll
            for (int i = 0; i < N; ++i) { const int l = i ^ j; if (l > i) { if ((i & k) == 0) CEX_D(v[i], v[l]); else CEX_D(v[l], v[i]); } }
}
__device__ __forceinline__ void bitonic_merge16_desc(float (&v)[16]) {
#pragma unroll
    for (int j = 8; j > 0; j >>= 1)
#pragma unroll
        for (int i = 0; i < 16; ++i) { const int l = i ^ j; if (l > i) CEX_D(v[i], v[l]); }
}
template <bool SWAP16> __device__ __forceinline__ void merge_partner16(float (&a)[16]) {
    float e[16], o[16];
#pragma unroll
    for (int i = 0; i < 16; ++i) {
        if (SWAP16) { auto r = __builtin_amdgcn_permlane16_swap(__float_as_uint(a[i]), __float_as_uint(a[i]), false, false); e[i] = __uint_as_float(r[0]); o[i] = __uint_as_float(r[1]); }
        else { auto r = __builtin_amdgcn_permlane32_swap(__float_as_uint(a[i]), __float_as_uint(a[i]), false, false); e[i] = __uint_as_float(r[0]); o[i] = __uint_as_float(r[1]); }
    }
#pragma unroll
    for (int i = 0; i < 16; ++i) a[i] = vmaxr(e[i], o[15 - i]);
    bitonic_merge16_desc(a);
}
__device__ __forceinline__ void phase_route(const Ctx& F, int layer) {
    const bf16_t* Q = (const bf16_t*)(F.ws + WS_Q);
    const bf16_t* KEYS = (const bf16_t*)(F.ws + WS_KEYS) + (size_t)layer * 8 * 2 * 128 * 64;
    unsigned short* IDX = (unsigned short*)(F.ws + WS_IDX); float* GATE = (float*)(F.ws + WS_GATE);
    const float* SSQ = (const float*)(F.ws + WS_SSQ) + (size_t)layer * MTOK * 16;
    const int lane = F.lane, c = lane & 15, g = lane >> 4;
    const int krow = F.wave * 16 + (lane >> 3), kch = lane & 7;
    const unsigned kw0 = (unsigned)krow * 128u + (unsigned)((kch ^ ((krow >> 1) & 7)) << 4), kw1 = (unsigned)(krow + 8) * 128u + (unsigned)((kch ^ (((krow + 8) >> 1) & 7)) << 4);
    const unsigned kra = (unsigned)c * 128u, ksw = (unsigned)((c >> 1) & 7);
    for (int ub = F.vcu * NWAVES; ub < MTOK / 16; ub += F.NGW) {
        const int unit = ub + F.wave;
        const int tok = unit * 16 + c;
        const bf16_t* qrow = Q + (size_t)tok * DM + g * 8;
        float ssq_; { const f32x4 t4 = *(const f32x4*)(SSQ + (size_t)tok * 16 + 4 * g); ssq_ = (t4.x + t4.y) + (t4.z + t4.w); ssq_ = swap16_sum(ssq_, ssq_); ssq_ = swap32_sum(ssq_, ssq_); }
        const float rsl = rsqrtf(ssq_ * (1.0f / DM) + EPS) * LOG2E;
        u32x4 kp0, kp1;
        { const bf16_t* ks = KEYS + (size_t)krow * 64 + kch * 8; kp0 = *(const u32x4*)ks; kp1 = *(const u32x4*)(ks + 8 * 64); }
        __syncthreads();
        *(LAS u32x4*)(F.lds + kw0) = kp0; *(LAS u32x4*)(F.lds + kw1) = kp1;
        __syncthreads();
#pragma unroll 1
        for (int h = 0; h < 8; ++h) {
            float sv0[16], sv1[16];
#pragma unroll
            for (int p = 0; p < 2; ++p) {
                const int hp = h * 2 + p;
                if (hp + 1 < 16) { const bf16_t* ks = KEYS + (size_t)((hp + 1) * 128 + krow) * 64 + kch * 8; kp0 = *(const u32x4*)ks; kp1 = *(const u32x4*)(ks + 8 * 64); }
                const bf16x8 bq0 = *(const bf16x8*)(qrow + h * 128 + p * 64), bq1 = *(const bf16x8*)(qrow + h * 128 + p * 64 + 32);
                LAS const unsigned char* kb = F.lds + p * 16384 + kra;
                float va[16], vb[16];
#pragma unroll
                for (int kt = 0; kt < 8; ++kt) {
                    const bf16x8 a0 = *(LAS const bf16x8*)(kb + kt * 2048 + (((unsigned)g ^ ksw) << 4)), a1 = *(LAS const bf16x8*)(kb + kt * 2048 + (((unsigned)(4 + g) ^ ksw) << 4));
                    f32x4 acc = {0.f, 0.f, 0.f, 0.f};
                    acc = __builtin_amdgcn_mfma_f32_16x16x32_bf16(a0, bq0, acc, 0, 0, 0);
                    acc = __builtin_amdgcn_mfma_f32_16x16x32_bf16(a1, bq1, acc, 0, 0, 0);
#pragma unroll
                    for (int r = 0; r < 4; ++r) { const float x = __uint_as_float((__float_as_uint(acc[r]) & 0xFFFFFF80u) | (unsigned)(kt * 16 + r) | (unsigned)(4 * g));
                        if (kt < 4) va[kt * 4 + r] = x; else vb[(kt - 4) * 4 + r] = x; }
                }
                if (hp + 1 < 16) { *(LAS u32x4*)(F.lds + (1 - p) * 16384 + kw0) = kp0; *(LAS u32x4*)(F.lds + (1 - p) * 16384 + kw1) = kp1; }
                __syncthreads();
                bitonic_sort_desc<16>(va); bitonic_sort_desc<16>(vb);
#pragma unroll
                for (int i = 0; i < 16; ++i) va[i] = vmaxr(va[i], vb[15 - i]);
                bitonic_merge16_desc(va);
                merge_partner16<true>(va); merge_partner16<false>(va);
#pragma unroll
                for (int i = 0; i < 16; ++i) { if (p == 0) sv0[i] = va[i]; else sv1[i] = va[i]; }
            }
            float t[4];
#pragma unroll
            for (int j = 0; j < 4; ++j) t[j] = (g == 0) ? sv1[4 * j] : (g == 1) ? sv1[4 * j + 1] : (g == 2) ? sv1[4 * j + 2] : sv1[4 * j + 3];
#define CANDV(a, j) __uint_as_float((__float_as_uint(sv0[a] + t[j]) & 0xFFFFC000u) | ((__float_as_uint(sv0[a]) & 0x7Fu) << 7) | (__float_as_uint(t[j]) & 0x7Fu))
            float w[16];
#pragma unroll
            for (int a = 0; a < 16; ++a) w[a] = CANDV(a, 0);
            {
                float x0 = CANDV(0, 1), x1 = CANDV(1, 1), x2 = CANDV(2, 1), x3 = CANDV(0, 2), x4 = CANDV(0, 3);
                CEX_D(x0, x1); CEX_D(x3, x4); CEX_D(x2, x4); CEX_D(x2, x3); CEX_D(x0, x3); CEX_D(x0, x2); CEX_D(x1, x4); CEX_D(x1, x3); CEX_D(x1, x2);
                w[15] = vmaxr(w[15], x0); w[14] = vmaxr(w[14], x1); w[13] = vmaxr(w[13], x2); w[12] = vmaxr(w[12], x3); w[11] = vmaxr(w[11], x4);
                bitonic_merge16_desc(w);
            }
#undef CANDV
            merge_partner16<true>(w); merge_partner16<false>(w);
            float e[16]; float den = 0.f;
#pragma unroll
            for (int k = 0; k < 16; ++k) { e[k] = __builtin_amdgcn_exp2f((w[k] - w[0]) * rsl); den += e[k]; }
            const float inv = 1.0f / den;
            if (g == 0) {
                unsigned iw[8];
#pragma unroll
                for (int k = 0; k < 8; ++k) iw[k] = (__float_as_uint(w[2 * k]) & 0x3FFFu) | ((__float_as_uint(w[2 * k + 1]) & 0x3FFFu) << 16);
                u32x4* ip = (u32x4*)(IDX + (size_t)tok * 128 + h * 16);
                ip[0] = (u32x4){iw[0], iw[1], iw[2], iw[3]}; ip[1] = (u32x4){iw[4], iw[5], iw[6], iw[7]};
                f32x4* gp = (f32x4*)(GATE + (size_t)tok * 128 + h * 16);
#pragma unroll
                for (int k = 0; k < 4; ++k) gp[k] = (f32x4){e[4 * k] * inv, e[4 * k + 1] * inv, e[4 * k + 2] * inv, e[4 * k + 3] * inv};
            }
        }
    }
}

template <int PART>
__device__ __forceinline__ void phase_gather(const Ctx& F, int layer) {
    const unsigned char* Ut = F.ws + WS_U + (size_t)layer * NEXP * ROWB;
    const unsigned char* Vt = F.ws + WS_V + (size_t)layer * NEXP * ROWB;
    const float* SU = (const float*)(F.ws + WS_SU) + (size_t)layer * NEXP; const float* SV = (const float*)(F.ws + WS_SV) + (size_t)layer * NEXP;
    const unsigned short* IDX = (const unsigned short*)(F.ws + WS_IDX); const float* GATE = (const float*)(F.ws + WS_GATE);
    const float* gn = F.in[7] + (size_t)layer * DM;
    float* ACT = (float*)(F.ws + WS_ACTG);
    const float* gnext = F.in[1] + (size_t)(layer + 1 < DEPTH ? layer + 1 : 0) * DM;
    const int lane = F.lane, k = lane & 31, hf = lane >> 5;
    const int b3 = lane & 8, b2 = lane & 4, b1 = lane & 2;
    for (int tok = F.gw; tok < MTOK; tok += F.NGW) {
        float* xr = F.out + (size_t)tok * DM + 4 * k;
        f32x32 xh;
        {   float ss = 0.f;
#pragma unroll
            for (int i = 0; i < 8; ++i) { const f32x4 t = *(const f32x4*)(xr + 128 * i); xh[4 * i] = t.x; xh[4 * i + 1] = t.y; xh[4 * i + 2] = t.z; xh[4 * i + 3] = t.w; ss += (t.x * t.x + t.y * t.y) + (t.z * t.z + t.w * t.w); }
            ss += dppf<DPP_XOR1>(ss); ss += dppf<DPP_XOR2>(ss); ss += dppf<DPP_HMIR>(ss); ss += dppf<DPP_RMIR>(ss); ss = swap16_sum(ss, ss);
            const float rs = rsqrtf(ss * (1.0f / DM) + EPS);
#pragma unroll
            for (int i = 0; i < 8; ++i) { const f32x4 g = *(const f32x4*)(gn + 4 * k + 128 * i); xh[4 * i] *= rs * g.x; xh[4 * i + 1] *= rs * g.y; xh[4 * i + 2] *= rs * g.z; xh[4 * i + 3] *= rs * g.w; } }
        const unsigned idxreg = ((const unsigned*)(IDX + (size_t)tok * 128))[lane];
        const int s0 = 2 * (16 * (k & 1) + (k >> 1)) + hf, s1 = 64 + s0;
        const unsigned e0 = IDX[(size_t)tok * 128 + s0], e1 = IDX[(size_t)tok * 128 + s1];
        const float gate0 = GATE[(size_t)tok * 128 + s0] * SV[e0], gate1 = GATE[(size_t)tok * 128 + s1] * SV[e1];
        const float su0 = SU[e0], su1 = SU[e1];
        float z0 = 0.f, z1 = 0.f;
#define G_LOAD(W_, T_, qb) do { _Pragma("unroll") for (int j = 0; j < 8; ++j) { \
            const unsigned wv = (unsigned)__builtin_amdgcn_readlane((int)idxreg, (qb) + j); const unsigned e = hf ? (wv >> 16) : (wv & 0xffffu); \
            W_[j] = *(const u32x6_a8*)(T_ + (size_t)e * ROWB + 24 * k); } } while (0)
#define G_UDOT(W_, P_, po) do { _Pragma("unroll") for (int j = 0; j < 8; ++j) { \
            const f32x32 d = __builtin_amdgcn_cvt_scalef32_pk32_f32_fp6(W_[j], 1.0f); f32x2_t ac[4]; \
            _Pragma("unroll") for (int c = 0; c < 4; ++c) ac[c] = (f32x2_t){d[2 * c], d[2 * c + 1]} * (f32x2_t){xh[2 * c], xh[2 * c + 1]}; \
            _Pragma("unroll") for (int i = 8; i < 32; i += 2) ac[(i >> 1) & 3] = (f32x2_t){d[i], d[i + 1]} * (f32x2_t){xh[i], xh[i + 1]} + ac[(i >> 1) & 3]; \
            const f32x2_t as_ = (ac[0] + ac[1]) + (ac[2] + ac[3]); P_[(po) + j] = as_.x + as_.y; } } while (0)
#define G_VACC(W_, qb) do { const float asel = ((qb) < 32) ? act0 : act1; _Pragma("unroll") for (int j = 0; j < 8; ++j) { \
            const int al_ = 2 * (((qb) + j) & 15) + ((((qb) + j) >> 4) & 1); \
            const float alo = __uint_as_float((unsigned)__builtin_amdgcn_readlane((int)__float_as_uint(asel), al_)); \
            const float ahi = __uint_as_float((unsigned)__builtin_amdgcn_readlane((int)__float_as_uint(asel), 32 + al_)); \
            const float a = hf ? ahi : alo; const f32x32 d = __builtin_amdgcn_cvt_scalef32_pk32_f32_fp6(W_[j], 1.0f); o = d * a + o; } } while (0)
        u32x6 wA[8], wB[8];
        if (PART == 0) {
            G_LOAD(wA, Ut, 0);
#pragma unroll 1
            for (int q0 = 0; q0 < 64; q0 += 16) {
                float p[16];
                G_LOAD(wB, Ut, q0 + 8);
                G_UDOT(wA, p, 0);
                if (q0 + 16 < 64) G_LOAD(wA, Ut, q0 + 16);
                G_UDOT(wB, p, 8);
                float q8[8], q4[4], q2[2];
#pragma unroll
                for (int j = 0; j < 8; ++j) q8[j] = swap16_sum(p[j], p[j + 8]);
#pragma unroll
                for (int j = 0; j < 4; ++j) { const float send = b3 ? q8[j] : q8[j + 4], keep = b3 ? q8[j + 4] : q8[j]; q4[j] = keep + dppf<DPP_RMIR>(send); }
#pragma unroll
                for (int j = 0; j < 2; ++j) { const float send = b2 ? q4[j] : q4[j + 2], keep = b2 ? q4[j + 2] : q4[j]; q2[j] = keep + dppf<DPP_HMIR>(send); }
                float pz;
                { const float send = b1 ? q2[0] : q2[1], keep = b1 ? q2[1] : q2[0]; pz = keep + dppf<DPP_XOR2>(send); }
                pz += dppf<DPP_XOR1>(pz);
                if ((k & 1) == ((q0 >> 4) & 1)) { if (q0 < 32) z0 = pz; else z1 = pz; }
            }
        }
        z0 *= su0; z1 *= su1;
        float act0, act1;
        if (PART == 0) { act0 = 0.5f * z0 * (1.0f + erff(z0 * 0.70710678118654752f)) * gate0; act1 = 0.5f * z1 * (1.0f + erff(z1 * 0.70710678118654752f)) * gate1; }
        else { act0 = ACT[(size_t)tok * 128 + s0]; act1 = ACT[(size_t)tok * 128 + s1]; }
        if (PART == 0) { ACT[(size_t)tok * 128 + s0] = act0; ACT[(size_t)tok * 128 + s1] = act1; continue; }
        f32x32 o;
#pragma unroll
        for (int i = 0; i < 32; ++i) o[i] = 0.f;
        G_LOAD(wA, Vt, 0);
#pragma unroll 1
        for (int q0 = 0; q0 < 64; q0 += 16) {
            G_LOAD(wB, Vt, q0 + 8);
            G_VACC(wA, q0);
            if (q0 + 16 < 64) G_LOAD(wA, Vt, q0 + 16);
            G_VACC(wB, q0 + 8);
        }
#undef G_LOAD
#undef G_UDOT
#undef G_VACC
        float xn[16]; float s2 = 0.f;
#pragma unroll
        for (int i = 0; i < 16; ++i) {
            const float tot = swap32_sum(o[i], o[i + 16]);
            xn[i] = tot;
        }
        float* xw = xr + 512 * hf;
#pragma unroll
        for (int i = 0; i < 4; ++i) { const f32x4 t = *(const f32x4*)(xw + 128 * i); xn[4 * i] += t.x; xn[4 * i + 1] += t.y; xn[4 * i + 2] += t.z; xn[4 * i + 3] += t.w; }
#pragma unroll
        for (int i = 0; i < 4; ++i) *(f32x4*)(xw + 128 * i) = (f32x4){xn[4 * i], xn[4 * i + 1], xn[4 * i + 2], xn[4 * i + 3]};
        if (layer + 1 < DEPTH) {
#pragma unroll
            for (int i = 0; i < 16; ++i) s2 += xn[i] * xn[i];
            const float rs2 = rsqrtf(wave_sum(s2) * (1.0f / DM) + EPS);
            const float* gp = gnext + 4 * k + 512 * hf;
            bf16_t* hr = (bf16_t*)(F.ws + WS_H) + (size_t)tok * DM + 4 * k + 512 * hf;
#pragma unroll
            for (int i = 0; i < 4; ++i) { const f32x4 g = *(const f32x4*)(gp + 128 * i);
                u32x2 w; w.x = cvtpk(xn[4 * i] * rs2 * g.x, xn[4 * i + 1] * rs2 * g.y); w.y = cvtpk(xn[4 * i + 2] * rs2 * g.z, xn[4 * i + 3] * rs2 * g.w);
                *(u32x2*)(hr + 128 * i) = w; }
        }
    }
}

#define GAS __attribute__((address_space(1)))
#define XB_TMO      128
#define XB_XCNT(j)  (256  + 64 * (j))
#define XB_XSUB(j)  (1280 + 64 * (j))
#define XB_XGEN(j)  (2304 + 64 * (j))
#define XB_TOP      3328
#define XB_TOPGEN   3392
#define XCD_BAR_WORDS 3456
#define XB_SPIN_CAP (1u << 18)

__device__ __forceinline__ unsigned xb_ld(unsigned* p)              { return __hip_atomic_load(p, __ATOMIC_RELAXED, __HIP_MEMORY_SCOPE_AGENT); }
__device__ __forceinline__ unsigned xb_add(unsigned* p, unsigned v) { return __hip_atomic_fetch_add(p, v, __ATOMIC_RELAXED, __HIP_MEMORY_SCOPE_AGENT); }
__device__ __forceinline__ unsigned xb_xcc_id() { return (unsigned)__builtin_amdgcn_s_getreg((3 << 11) | 20) & 0xFu; }
#define XB_SPIN(cond, bar) do { unsigned _sp = 0; while (cond) { __builtin_amdgcn_s_sleep(1); \
    if ((++_sp & 255u) == 0u) { if (xb_ld(&(bar)[XB_TMO])) break; if (_sp > XB_SPIN_CAP) { atomicAdd(&(bar)[XB_TMO], 1u); break; } } } } while (0)

struct XcdBarrier {
    unsigned* bar; unsigned x;
    volatile LAS unsigned* st;
};

__device__ __forceinline__ XcdBarrier xcd_barrier_post(unsigned* bar, volatile LAS unsigned* st) {
    XcdBarrier b; b.bar = bar; b.x = xb_xcc_id(); b.st = st;
    if (threadIdx.x == 0) (void)xb_add(&bar[XB_XCNT(b.x)], 1u);
    return b;
}
__device__ __forceinline__ void xcd_barrier_complete(unsigned* bar, unsigned x, unsigned& nloc, unsigned& nx) {
    const unsigned G = gridDim.x * gridDim.y * gridDim.z;
    unsigned sum, cnt, mine, sp = 0u;
    for (;;) {
        sum = 0u; cnt = 0u; mine = 0u;
#pragma unroll
        for (unsigned j = 0; j < 16; ++j) { const unsigned c = xb_ld(&bar[XB_XCNT(j)]); sum += c; cnt += (c > 0u) ? 1u : 0u; mine = (j == x) ? c : mine; }
        if (sum == G) break;
        __builtin_amdgcn_s_sleep(1);
        if ((++sp & 255u) == 0u) { if (xb_ld(&bar[XB_TMO])) break; if (sp > XB_SPIN_CAP) { atomicAdd(&bar[XB_TMO], 1u); break; } }
    }
    nloc = mine > 0u ? mine : 1u; nx = cnt > 0u ? cnt : 1u;
}

__device__ __forceinline__ void xcd_barrier(const XcdBarrier& b) {
    asm volatile("s_waitcnt vmcnt(0)" ::: "memory");
    __syncthreads();
    if (threadIdx.x == 0) {
        unsigned* bar = b.bar;
        __builtin_amdgcn_s_waitcnt(0);
        unsigned nloc = b.st[0], nx = b.st[1];
        if (nloc == 0u) { xcd_barrier_complete(bar, b.x, nloc, nx); b.st[0] = nloc; b.st[1] = nx; }
        const unsigned old = xb_add(&bar[XB_XSUB(b.x)], 1u);
        const unsigned gen = old / nloc;
        if (old + 1u == (gen + 1u) * nloc) {
            __builtin_amdgcn_fence(__ATOMIC_RELEASE, "agent");
            asm volatile("s_waitcnt vmcnt(0)" ::: "memory");
            const unsigned og = xb_add(&bar[XB_TOP], 1u);
            const unsigned tg = og / nx;
            if (og + 1u == (tg + 1u) * nx) xb_add(&bar[XB_TOPGEN], 1u);
            else XB_SPIN(xb_ld(&bar[XB_TOPGEN]) == tg, bar);
            __builtin_amdgcn_fence(__ATOMIC_ACQUIRE, "agent");
            xb_add(&bar[XB_XGEN(b.x)], 1u);
            asm volatile("s_waitcnt vmcnt(0)" ::: "memory");
        } else {
            XB_SPIN(xb_ld(&bar[XB_XGEN(b.x)]) == gen, bar);
            __builtin_amdgcn_fence(__ATOMIC_ACQUIRE, "agent");
            asm volatile("s_waitcnt vmcnt(0)" ::: "memory");
        }
    }
    __syncthreads();
}

constexpr int PH_PER_LAYER = 9;
constexpr int N_PHASES = 1 + PH_PER_LAYER * DEPTH;
struct Args { const float* in[12]; float* out; unsigned char* ws; int ph_lo, ph_hi; };
__global__ void __launch_bounds__(NTHREADS, 2) mk_fwd(Args args) {
    extern __shared__ __attribute__((aligned(16))) unsigned char lds_raw[];
#define MKCTX() Ctx F; { int t_ = threadIdx.x, b_ = blockIdx.x; asm volatile("" : "+v"(t_)); asm volatile("" : "+s"(b_)); \
        F.lds = (LAS unsigned char*)lds_raw; F.tid = t_; F.lane = t_ & 63; F.wave = __builtin_amdgcn_readfirstlane(t_ >> 6); F.G = gridDim.x; \
        F.vcu = (F.G % 8 == 0) ? (b_ % 8) * (F.G / 8) + b_ / 8 : b_; F.gw = F.vcu * NWAVES + F.wave; F.NGW = F.G * NWAVES; F.in = args.in; F.out = args.out; F.ws = args.ws; }
    const int lo = args.ph_lo, hi = args.ph_hi;
    volatile LAS unsigned* MISC = (volatile LAS unsigned*)((LAS unsigned char*)lds_raw + 131072);
    if (threadIdx.x < 16) MISC[threadIdx.x] = 0u;
    __syncthreads();
    XcdBarrier bar = xcd_barrier_post((unsigned*)(args.ws + WS_CTL) + 4096, MISC + 8);
#define IN(k) (lo <= (k) && (k) < hi)
#define SEAM(k) do { if (IN(k) && IN((k) + 1)) { if ((k) == 0) cg::this_grid().sync(); else xcd_barrier(bar); } } while (0)
#ifndef DUP_PH
#define DUP_PH -1
#endif
#define PH(k, kk, ...) do { if (IN(k)) { __VA_ARGS__; if (DUP_PH == (kk)) { xcd_barrier(bar); __VA_ARGS__; } } SEAM(k); } while (0)
    PH(0, 0, { MKCTX(); phase_p0(F); });
#pragma unroll 1
    for (int l = 0; l < DEPTH; ++l) {
        const int pb = 1 + PH_PER_LAYER * l;
        bf16_t* H = (bf16_t*)(args.ws + WS_H);
        PH(pb + 0, 1, {
            pg8::Gemm g{H, (const bf16_t*)(args.ws + WS_WIN) + (size_t)l * PW * DM, MTOK, PW, DM}; pg8::StaticOrder S; S.init(MTOK, PW, (int)gridDim.x, (int)blockIdx.x);
            pg8::EpiBf16 E{(bf16_t*)(args.ws + WS_P), PW};
            pg8::gemm_phase<pg8::EpiBf16, pg8::StaticOrder, true, true>((LAS unsigned char*)lds_raw, g, S, E); });
        PH(pb + 1, -2, { MKCTX(); phase_rope(F, F.in[3] + l * 384); });
        PH(pb + 2, 3, { MKCTX(); phase_attn(F, F.in[4] + l * 4, F.in[3] + l * 384); });
        PH(pb + 3, 4, { MKCTX(); phase_post(F, F.in[5] + l * DM); });
        PH(pb + 4, -2, {
            pg8::Gemm g{H, (const bf16_t*)(args.ws + WS_WOUT) + (size_t)l * DM * DM, MTOK, DM, DM}; pg8::StaticOrder S; S.init(MTOK, DM, (int)gridDim.x, (int)blockIdx.x);
            pg8::EpiResF32 E{l == 0 ? args.in[0] : args.out, args.out, (bf16_t*)(args.ws + WS_X1B), (float*)(args.ws + WS_SSQ) + (size_t)l * MTOK * 16, DM};
            pg8::gemm_phase<pg8::EpiResF32, pg8::StaticOrder, true, true>((LAS unsigned char*)lds_raw, g, S, E); });
        PH(pb + 5, 7, {
            pg8::Gemm g{(const bf16_t*)(args.ws + WS_X1B), (const bf16_t*)(args.ws + WS_WQ) + (size_t)l * DM * DM, MTOK, DM, DM}; pg8::StaticOrder S; S.init(MTOK, DM, (int)gridDim.x, (int)blockIdx.x);
            pg8::EpiBf16 E{(bf16_t*)(args.ws + WS_Q), DM};
            pg8::gemm_phase<pg8::EpiBf16, pg8::StaticOrder, true, true>((LAS unsigned char*)lds_raw, g, S, E); });
        PH(pb + 6, 8, { MKCTX(); phase_route(F, l); });
        PH(pb + 7, -2, { MKCTX(); phase_gather<0>(F, l); });
        PH(pb + 8, -2, { MKCTX(); phase_gather<1>(F, l); });
    }
#undef IN
#undef SEAM
}

#ifndef MK_ONE_LAUNCH
#define MK_ONE_LAUNCH 1
#endif
extern "C" void kernel_launch(void* const* d_in, const int* in_sizes, int n_in, void* d_out, int out_size, void* d_ws, size_t ws_size, hipStream_t stream) {
    static int grid = 0;
    if (grid == 0) {
        if (n_in != 12 || ws_size < WS_END) { fprintf(stderr, "kernel_launch: unexpected n_in %d / ws %zu\n", n_in, ws_size); grid = -1; return; }
        int dev = 0, cus = 0, per_cu = 0;
        if (hipGetDevice(&dev) != hipSuccess || hipDeviceGetAttribute(&cus, hipDeviceAttributeMultiprocessorCount, dev) != hipSuccess) { grid = -1; return; }
        if (hipFuncSetAttribute((const void*)mk_fwd, hipFuncAttributeMaxDynamicSharedMemorySize, LDS_BYTES) != hipSuccess) { fprintf(stderr, "kernel_launch: hipFuncSetAttribute failed\n"); grid = -1; return; }
        if (hipOccupancyMaxActiveBlocksPerMultiprocessor(&per_cu, (const void*)mk_fwd, NTHREADS, LDS_BYTES) != hipSuccess || per_cu < 1) { fprintf(stderr, "kernel_launch: occupancy query failed (%d)\n", per_cu); (void)hipGetLastError(); grid = -1; return; }
        grid = cus * per_cu;
        fprintf(stderr, "kernel_launch: cus %d per_cu %d grid %d\n", cus, per_cu, grid);
    }
    if (grid < 0) return;
    if (hipMemsetAsync((char*)d_ws + WS_CTL, 0, CTL_BYTES, stream) != hipSuccess) { fprintf(stderr, "kernel_launch: memset failed\n"); return; }
    Args a{};
    for (int i = 0; i < 12; ++i) a.in[i] = (const float*)d_in[i];
    a.out = (float*)d_out; a.ws = (unsigned char*)d_ws;
#if MK_ONE_LAUNCH
    a.ph_lo = 0; a.ph_hi = N_PHASES;
    void* kargs[] = {&a};
    hipError_t e = hipLaunchCooperativeKernel((const void*)mk_fwd, dim3(grid), dim3(NTHREADS), kargs, LDS_BYTES, stream);
    if (e != hipSuccess) fprintf(stderr, "cooperative launch failed: %s (grid %d)\n", hipGetErrorString(e), grid);
#else
    for (int p = 0; p < N_PHASES; ++p) { a.ph_lo = p; a.ph_hi = p + 1; hipLaunchKernelGGL(mk_fwd, dim3(grid), dim3(NTHREADS), LDS_BYTES, stream, a); }
#endif
}
```

```cpp
#include <hip/hip_runtime.h>
#include <hip/hip_cooperative_groups.h>
#include <cstdio>
#include <cstdint>
#include <cmath>
namespace cg = cooperative_groups;

constexpr int BATCH = 16, SEQ = 2048, DM = 1024, DEPTH = 2;
constexpr int MTOK = BATCH * SEQ;
constexpr int PW = 2304;
constexpr int NKEYS = 128, NEXP = NKEYS * NKEYS;
constexpr float EPS = 1e-6f;
constexpr int C_QA = 0, C_KA = 384, C_VA = 512, C_QB = 640, C_KB = 1024, C_VB = 1408, C_QC = 1792, C_KC = 2048, C_VC = 2176;
constexpr float LOG2E = 1.4426950408889634f;
constexpr float QSCALE = 0.125f * LOG2E;

#define LAS __attribute__((address_space(3)))
typedef unsigned short bf16_t;
typedef short bf16x8 __attribute__((ext_vector_type(8)));
typedef short s16x4 __attribute__((ext_vector_type(4)));
typedef float f32x4 __attribute__((ext_vector_type(4)));
typedef float f32x16 __attribute__((ext_vector_type(16)));
typedef unsigned u32x4 __attribute__((ext_vector_type(4)));
typedef unsigned u32x2 __attribute__((ext_vector_type(2)));
typedef float f32x2_t __attribute__((ext_vector_type(2)));
typedef float f32x32 __attribute__((ext_vector_type(32)));
typedef unsigned u32x6 __attribute__((ext_vector_type(6)));
typedef u32x6 u32x6_a8 __attribute__((aligned(8)));
typedef __bf16 bf16x2_t __attribute__((ext_vector_type(2)));

__device__ __forceinline__ unsigned cvtpk(float lo, float hi) { f32x2_t v = {lo, hi}; bf16x2_t b = __builtin_convertvector(v, bf16x2_t); return __builtin_bit_cast(unsigned, b); }
__device__ __forceinline__ float bf_lo(unsigned w) { return __uint_as_float(w << 16); }
__device__ __forceinline__ float bf_hi(unsigned w) { return __uint_as_float(w & 0xffff0000u); }
template <int CTRL> __device__ __forceinline__ float dppf(float x) { return __uint_as_float((unsigned)__builtin_amdgcn_update_dpp(0, (int)__float_as_uint(x), CTRL, 0xF, 0xF, true)); }
#define DPP_XOR1 0xB1
#define DPP_XOR2 0x4E
#define DPP_XOR3 0x1B
#define DPP_HMIR 0x141
#define DPP_RMIR 0x140
__device__ __forceinline__ float swap16_sum(float a, float b) { auto r = __builtin_amdgcn_permlane16_swap(__float_as_uint(a), __float_as_uint(b), false, false); return __uint_as_float(r[0]) + __uint_as_float(r[1]); }
__device__ __forceinline__ float swap32_sum(float a, float b) { auto r = __builtin_amdgcn_permlane32_swap(__float_as_uint(a), __float_as_uint(b), false, false); return __uint_as_float(r[0]) + __uint_as_float(r[1]); }
__device__ __forceinline__ float swap16_max(float a) { auto r = __builtin_amdgcn_permlane16_swap(__float_as_uint(a), __float_as_uint(a), false, false); return fmaxf(__uint_as_float(r[0]), __uint_as_float(r[1])); }
__device__ __forceinline__ float swap32_max(float a) { auto r = __builtin_amdgcn_permlane32_swap(__float_as_uint(a), __float_as_uint(a), false, false); return fmaxf(__uint_as_float(r[0]), __uint_as_float(r[1])); }
__device__ __forceinline__ float wave_sum(float v) {
    v += dppf<DPP_XOR1>(v); v += dppf<DPP_XOR2>(v); v += dppf<DPP_HMIR>(v); v += dppf<DPP_RMIR>(v);
    v = swap16_sum(v, v); v = swap32_sum(v, v);
    return v;
}
__device__ __forceinline__ float wave_max(float v) {
    v = fmaxf(v, dppf<DPP_XOR1>(v)); v = fmaxf(v, dppf<DPP_XOR2>(v)); v = fmaxf(v, dppf<DPP_HMIR>(v)); v = fmaxf(v, dppf<DPP_RMIR>(v));
    v = swap16_max(v); v = swap32_max(v);
    return v;
}

constexpr size_t MiB = 1u << 20;
constexpr size_t WS_CTL = 0, CTL_BYTES = 1 * MiB;
constexpr size_t WS_WIN = 1 * MiB;
constexpr size_t WS_WOUT = 10 * MiB;
constexpr size_t WS_WQ = 14 * MiB;
constexpr size_t WS_KEYS = 18 * MiB;
constexpr size_t WS_LSE = 19 * MiB;
constexpr size_t WS_ROPE = 22 * MiB;
constexpr size_t WS_U = 24 * MiB;
constexpr size_t WS_V = 48 * MiB;
constexpr int ROWB = 768;
constexpr size_t WS_SU = 72 * MiB;
constexpr size_t WS_SV = 73 * MiB;
constexpr size_t WS_H = 152 * MiB;
constexpr size_t WS_P = 216 * MiB;
constexpr size_t WS_MIX = 360 * MiB;
constexpr size_t WS_OB = 424 * MiB;
constexpr size_t WS_END = 496 * MiB;
constexpr size_t WS_X1B = 88 * MiB;
constexpr size_t WS_SSQ = 74 * MiB;
constexpr size_t WS_ACTG = WS_P + 96 * MiB;
constexpr size_t WS_Q = WS_P;
constexpr size_t WS_IDX = WS_P + 64 * MiB;
constexpr size_t WS_GATE = WS_P + 72 * MiB;

constexpr int NWAVES = 8, NTHREADS = 512;
constexpr int LDS_BYTES = 147456;

namespace pg8 {
using ::u32x2;
#define PG8_LAS __attribute__((address_space(3)))
typedef unsigned short bf16_t;
typedef short bf16x8 __attribute__((ext_vector_type(8)));
typedef float f32x4 __attribute__((ext_vector_type(4)));
typedef unsigned u32x4 __attribute__((ext_vector_type(4)));
constexpr int BM = 256, BK = 64, HALF = 128, HTB = HALF * BK * 2  , STAGE_BYTES = 8 * HTB, NXCD = 8, WGM = 8;

__host__ __device__ __forceinline__ int lds_byte(int r, int c) { const int st = (r >> 4) * 2 + (c >> 5), rr = r & 15, cc = c & 31, ob = rr * 64 + cc * 2; return st * 1024 + (ob ^ (((ob >> 9) & 1) << 5)); }
__host__ __device__ __forceinline__ void stage_rc(int b, int& R, int& C) { const int st = b / 1024, sb = b % 1024, swz = sb ^ (((sb >> 9) & 1) << 5); R = (st >> 1) * 16 + swz / 64; C = (st & 1) * 32 + (swz % 64) / 2; }
__host__ __device__ __forceinline__ int perm32(int rho) { const int n = rho >> 4, i = rho & 15; return 8 * (i >> 2) + 4 * n + (i & 3); }

struct Unit { int pm, pn; };
struct Gemm { const bf16_t* A; const bf16_t* Bt; int M, N, K; };

struct StaticOrder {
    int nM, nN, nwg, G, c;
    __host__ __device__ void init(int M, int N, int G_, int c_) { nM = M / BM; nN = N / BM; nwg = nM * nN; G = G_; c = c_; }
    __host__ __device__ bool next(int i, Unit& u) const {
        const long L = (long)i * G + c; if (L >= nwg) return false;
        int wgid = (int)L; { const int q = nwg / NXCD, r = nwg % NXCD, xcd = wgid % NXCD, off = wgid / NXCD; wgid = (xcd < r ? xcd * (q + 1) : r * (q + 1) + (xcd - r) * q) + off; }
        const int nig = WGM * nN, gid = wgid / nig, fm = gid * WGM, gsz = (nM - fm) < WGM ? (nM - fm) : WGM;
        u.pm = fm + ((wgid % nig) % gsz); u.pn = (wgid % nig) / gsz; return true;
    }
    __device__ __forceinline__ void a_ready(const Unit&) const {}
    __device__ __forceinline__ void done(const Unit&) const {}
};


struct EpiBf16 {
    static constexpr bool PERM = true, AFTER_DRAIN = false;
    bf16_t* O; int ldc;
    __device__ __forceinline__ void operator()(const f32x4 (&acc)[2][2][4][2], const Unit& u, int wr, int wc, int fr, int fq) const {
        const int row0 = u.pm * BM + wr * 64 + fr; const int col0 = u.pn * BM + wc * 32 + 8 * fq;
#pragma unroll
        for (int ai = 0; ai < 2; ++ai)
#pragma unroll
            for (int m = 0; m < 4; ++m) { bf16_t* rowp = O + (size_t)(row0 + ai * HALF + m * 16) * ldc + col0;
#pragma unroll
                for (int bj = 0; bj < 2; ++bj) { const f32x4 v0 = acc[ai][bj][m][0], v1 = acc[ai][bj][m][1];
                    u32x4 w; w.x = ::cvtpk(v0[0], v0[1]); w.y = ::cvtpk(v0[2], v0[3]); w.z = ::cvtpk(v1[0], v1[1]); w.w = ::cvtpk(v1[2], v1[3]);
                    *(u32x4*)(rowp + bj * HALF) = w; } }
    }
};
template <bool BASE_F32>
struct EpiResBf16 {
    static constexpr bool PERM = true, AFTER_DRAIN = false;
    const void* base; bf16_t* Xb; float* ssq; int ldc;
    __device__ __forceinline__ void operator()(const f32x4 (&acc)[2][2][4][2], const Unit& u, int wr, int wc, int fr, int fq) const {
        const int row0 = u.pm * BM + wr * 64 + fr, col0 = u.pn * BM + wc * 32 + 8 * fq;
#pragma unroll
        for (int ai = 0; ai < 2; ++ai)
#pragma unroll
            for (int m = 0; m < 4; ++m) { const int row = row0 + ai * HALF + m * 16; const size_t off = (size_t)row * ldc + col0; float s = 0.f;
#pragma unroll
                for (int bj = 0; bj < 2; ++bj) { f32x4 v0 = acc[ai][bj][m][0], v1 = acc[ai][bj][m][1];
                    if (BASE_F32) { const float* bp = (const float*)base + off + bj * HALF; v0 = v0 + *(const f32x4*)bp; v1 = v1 + *(const f32x4*)(bp + 4); }
                    else { const u32x4 b = *(const u32x4*)((const bf16_t*)base + off + bj * HALF);
                        v0 = v0 + (f32x4){::bf_lo(b.x), ::bf_hi(b.x), ::bf_lo(b.y), ::bf_hi(b.y)}; v1 = v1 + (f32x4){::bf_lo(b.z), ::bf_hi(b.z), ::bf_lo(b.w), ::bf_hi(b.w)}; }
                    s += ((v0[0] * v0[0] + v0[1] * v0[1]) + (v0[2] * v0[2] + v0[3] * v0[3])) + ((v1[0] * v1[0] + v1[1] * v1[1]) + (v1[2] * v1[2] + v1[3] * v1[3]));
                    u32x4 w; w.x = ::cvtpk(v0[0], v0[1]); w.y = ::cvtpk(v0[2], v0[3]); w.z = ::cvtpk(v1[0], v1[1]); w.w = ::cvtpk(v1[2], v1[3]);
                    *(u32x4*)(Xb + off + bj * HALF) = w; }
                s = ::swap16_sum(s, s); s = ::swap32_sum(s, s);
                if (fq == 0) ssq[(size_t)row * 16 + u.pn * 4 + wc] = s; }
    }
};

template <class Epi, class Sched, bool ALIGN_EPI = false, bool SP2 = false>
__device__ __forceinline__ void gemm_phase(PG8_LAS unsigned char* lds, const Gemm g, const Sched& S, const Epi& E) {
    int tid_l = threadIdx.x; asm volatile("" : "+v"(tid_l));
    const int tid = tid_l, wid = __builtin_amdgcn_readfirstlane(tid >> 6), lane = tid & 63, wr = wid >> 2, wc = wid & 3, fr = lane & 15, fq = lane >> 4;
    const int K = g.K, nt = K / BK;
    unsigned voffA[2], voffB[2];
#pragma unroll
    for (int i = 0; i < 2; ++i) { int R, C; stage_rc(tid * 16 + i * 8192, R, C); const int Rb = Epi::PERM ? ((R & ~31) + perm32(R & 31)) : R;
        voffA[i] = (unsigned)(R * K + C) * 2u; voffB[i] = (unsigned)(Rb * K + C) * 2u; }
    const size_t kstep = (size_t)(BK * 2);
    const size_t hstep = (size_t)HALF * K * 2;
    const size_t tstep = 2 * hstep;
    const unsigned ldsw = (unsigned)wid * 1024u;
    const int aoff = lds_byte(wr * 64 + fr, fq * 8), boff = lds_byte(wc * 32 + fr, fq * 8);
#define PG8_SA(b, h) (((b) * 2 + (h)) * HTB)
#define PG8_SB(b, h) ((4 + (b) * 2 + (h)) * HTB)
#define PG8_STAGE(bufoff, gbase, voff) do { _Pragma("unroll") for (int _i = 0; _i < 2; ++_i) \
        __builtin_amdgcn_global_load_lds((const unsigned*)((const char*)(gbase) + (voff)[_i]), (PG8_LAS unsigned*)(lds + (bufoff) + ldsw + _i * 8192), 16, 0, 0); } while (0)
#define PG8_LDA(dst, b, h) do { _Pragma("unroll") for (int m = 0; m < 4; ++m) _Pragma("unroll") for (int k = 0; k < 2; ++k) dst[m][k] = *(const PG8_LAS bf16x8*)(lds + PG8_SA(b, h) + aoff + m * 2048 + k * 1024); } while (0)
#define PG8_LDB(dst, b, h) do { _Pragma("unroll") for (int n = 0; n < 2; ++n) _Pragma("unroll") for (int k = 0; k < 2; ++k) dst[n][k] = *(const PG8_LAS bf16x8*)(lds + PG8_SB(b, h) + boff + n * 2048 + k * 1024); } while (0)
#define PG8_MMA(ai, bj, At, Bt) do { __builtin_amdgcn_s_setprio(1); _Pragma("unroll") for (int m = 0; m < 4; ++m) _Pragma("unroll") for (int n = 0; n < 2; ++n) _Pragma("unroll") for (int k = 0; k < 2; ++k) \
        acc[ai][bj][m][n] = __builtin_amdgcn_mfma_f32_16x16x32_bf16(Bt[n][k], At[m][k], acc[ai][bj][m][n], 0, 0, 0); __builtin_amdgcn_s_setprio(0); } while (0)
#define PG8_WAIT_V(n) asm volatile("s_waitcnt vmcnt(" #n ")" ::: "memory")
#define PG8_WAIT_L(n) asm volatile("s_waitcnt lgkmcnt(" #n ")" ::: "memory")
#define PG8_BAR __builtin_amdgcn_s_barrier()
#define PG8_SCHED __builtin_amdgcn_sched_barrier(0)
    Unit cur, nxt; int ui = 0;
    if (!S.next(0, cur)) return;
    f32x4 acc[2][2][4][2];
#pragma unroll
    for (int a = 0; a < 2; ++a)
#pragma unroll
        for (int b = 0; b < 2; ++b)
#pragma unroll
            for (int m = 0; m < 4; ++m)
#pragma unroll
                for (int n = 0; n < 2; ++n) acc[a][b][m][n] = (f32x4){0.f, 0.f, 0.f, 0.f};
    bf16x8 At[4][2], B0[2][2], B1[2][2];
    const char* cA = (const char*)g.A + (size_t)cur.pm * tstep; const char* cB = (const char*)g.Bt + (size_t)cur.pn * tstep;
    S.a_ready(cur);
    if constexpr (SP2) {
        PG8_STAGE(PG8_SB(0, 0), cB, voffB); PG8_STAGE(PG8_SB(0, 1), cB + hstep, voffB); PG8_STAGE(PG8_SA(0, 0), cA, voffA); PG8_STAGE(PG8_SA(0, 1), cA + hstep, voffA);
        if (wr == 1) PG8_BAR;
        PG8_WAIT_V(2); PG8_BAR;
        PG8_STAGE(PG8_SB(1, 0), cB + kstep, voffB); PG8_STAGE(PG8_SA(1, 0), cA + kstep, voffA); PG8_STAGE(PG8_SB(1, 1), cB + hstep + kstep, voffB);
        PG8_WAIT_V(6); PG8_BAR;
    } else {
        PG8_STAGE(PG8_SB(0, 0), cB, voffB); PG8_STAGE(PG8_SA(0, 0), cA, voffA); PG8_STAGE(PG8_SB(0, 1), cB + hstep, voffB); PG8_STAGE(PG8_SA(0, 1), cA + hstep, voffA);
        if (wr == 1) PG8_BAR;
        PG8_WAIT_V(4); PG8_BAR;
        PG8_STAGE(PG8_SB(1, 0), cB + kstep, voffB); PG8_STAGE(PG8_SA(1, 0), cA + kstep, voffA); PG8_STAGE(PG8_SB(1, 1), cB + hstep + kstep, voffB);
        PG8_WAIT_V(6); PG8_BAR;
    }
    for (;;) {
        const bool has_next = S.next(ui + 1, nxt);
        const char* nA = has_next ? (const char*)g.A + (size_t)nxt.pm * tstep : cA; const char* nB = has_next ? (const char*)g.Bt + (size_t)nxt.pn * tstep : cB;
        for (int t = 0; t < nt; t += 2) {
            const bool last = (t == nt - 2);
            const char* a1 = cA + (size_t)(t + 1) * kstep;
            const char* a2 = last ? nA : cA + (size_t)(t + 2) * kstep; const char* b2 = last ? nB : cB + (size_t)(t + 2) * kstep;
            const char* a3 = a2 + kstep; const char* b3 = b2 + kstep;
            if (last && has_next) S.a_ready(nxt);
            if constexpr (SP2) {
            PG8_LDB(B0, 0, 0); PG8_LDB(B1, 0, 1); PG8_SCHED; PG8_LDA(At, 0, 0); PG8_STAGE(PG8_SA(1, 1), a1 + hstep, voffA);
            PG8_WAIT_V(8); PG8_WAIT_L(0); PG8_BAR; PG8_MMA(0, 0, At, B0); PG8_MMA(0, 1, At, B1); PG8_BAR; PG8_SCHED;
            PG8_LDA(At, 0, 1); PG8_STAGE(PG8_SB(0, 0), b2, voffB); PG8_STAGE(PG8_SB(0, 1), b2 + hstep, voffB); PG8_STAGE(PG8_SA(0, 0), a2, voffA);
            PG8_WAIT_V(8); PG8_WAIT_L(0); PG8_BAR; PG8_MMA(1, 0, At, B0); PG8_MMA(1, 1, At, B1); PG8_BAR; PG8_SCHED;
            PG8_LDB(B0, 1, 0); PG8_LDB(B1, 1, 1); PG8_SCHED; PG8_LDA(At, 1, 0); PG8_STAGE(PG8_SA(0, 1), a2 + hstep, voffA);
            PG8_WAIT_V(8); PG8_WAIT_L(0); PG8_BAR; PG8_MMA(0, 0, At, B0); PG8_MMA(0, 1, At, B1); PG8_BAR; PG8_SCHED;
            PG8_LDA(At, 1, 1); PG8_STAGE(PG8_SB(1, 0), b3, voffB); PG8_STAGE(PG8_SB(1, 1), b3 + hstep, voffB); PG8_STAGE(PG8_SA(1, 0), a3, voffA);
            PG8_WAIT_V(8); PG8_WAIT_L(0); PG8_BAR; PG8_MMA(1, 0, At, B0); PG8_MMA(1, 1, At, B1); PG8_BAR; PG8_SCHED;
            } else {
            PG8_LDB(B0, 0, 0); PG8_SCHED; PG8_LDA(At, 0, 0); PG8_STAGE(PG8_SA(1, 1), a1 + hstep, voffA);
            PG8_WAIT_L(8); PG8_BAR; PG8_WAIT_L(0); PG8_MMA(0, 0, At, B0); PG8_BAR; PG8_SCHED;
            PG8_LDB(B1, 0, 1); PG8_STAGE(PG8_SB(0, 0), b2, voffB);
            PG8_BAR; PG8_WAIT_L(0); PG8_MMA(0, 1, At, B1); PG8_BAR;
            PG8_LDA(At, 0, 1); PG8_STAGE(PG8_SA(0, 0), a2, voffA);
            PG8_BAR; PG8_WAIT_L(0); PG8_MMA(1, 0, At, B0); PG8_BAR; PG8_SCHED;
            PG8_STAGE(PG8_SB(0, 1), b2 + hstep, voffB);
            PG8_WAIT_V(6); PG8_BAR; PG8_MMA(1, 1, At, B1); PG8_BAR;
            PG8_LDB(B0, 1, 0); PG8_SCHED; PG8_LDA(At, 1, 0); PG8_STAGE(PG8_SA(0, 1), a2 + hstep, voffA);
            PG8_WAIT_L(8); PG8_BAR; PG8_WAIT_L(0); PG8_MMA(0, 0, At, B0); PG8_BAR; PG8_SCHED;
            PG8_LDB(B1, 1, 1); PG8_STAGE(PG8_SB(1, 0), b3, voffB);
            PG8_BAR; PG8_WAIT_L(0); PG8_MMA(0, 1, At, B1); PG8_BAR;
            PG8_LDA(At, 1, 1); PG8_STAGE(PG8_SA(1, 0), a3, voffA);
            PG8_BAR; PG8_WAIT_L(0); PG8_MMA(1, 0, At, B0); PG8_BAR; PG8_SCHED;
            PG8_STAGE(PG8_SB(1, 1), b3 + hstep, voffB);
            PG8_WAIT_V(6); PG8_BAR; PG8_MMA(1, 1, At, B1); PG8_BAR;
            }
        }
        if constexpr (ALIGN_EPI) { if (wr == 0) PG8_BAR; }
        if constexpr (!Epi::AFTER_DRAIN) { E(acc, cur, wr, wc, fr, fq); S.done(cur); }
        if (!has_next) break;
#pragma unroll
        for (int a = 0; a < 2; ++a)
#pragma unroll
            for (int b = 0; b < 2; ++b)
#pragma unroll
                for (int m = 0; m < 4; ++m)
#pragma unroll
                    for (int n = 0; n < 2; ++n) acc[a][b][m][n] = (f32x4){0.f, 0.f, 0.f, 0.f};
        cur = nxt; cA = nA; cB = nB; ++ui;
        if constexpr (ALIGN_EPI) { if (wr == 1) PG8_BAR; }
    }
    PG8_WAIT_V(0);
    if constexpr (!ALIGN_EPI) { if (wr == 0) PG8_BAR; }
    PG8_BAR;
    if constexpr (Epi::AFTER_DRAIN) { E.fused(acc, cur, wr, wc, fr, fq, lds, wid, lane); S.done(cur); }
#undef PG8_SA
#undef PG8_SB
#undef PG8_STAGE
#undef PG8_LDA
#undef PG8_LDB
#undef PG8_MMA
#undef PG8_WAIT_V
#undef PG8_WAIT_L
#undef PG8_BAR
#undef PG8_SCHED
}
}

__device__ __forceinline__ int crow(int r, int hi) { return (r & 3) + 8 * (r >> 2) + 4 * hi; }
__device__ __forceinline__ float fmax3(float a, float b, float c) { return fmaxf(fmaxf(a, b), c); }

__device__ __forceinline__ void norm_row_to_bf16(const float* xrow, const float* g, bf16_t* orow, int lane) {
    const f32x4* xr = (const f32x4*)xrow + lane;
    const f32x4* gr = (const f32x4*)g + lane;
    f32x4 v[4]; float s = 0.f;
#pragma unroll
    for (int j = 0; j < 4; ++j) { v[j] = xr[64 * j]; s += (v[j].x * v[j].x + v[j].y * v[j].y) + (v[j].z * v[j].z + v[j].w * v[j].w); }
    const float rs = rsqrtf(wave_sum(s) * (1.0f / DM) + EPS);
    u32x2* o8 = (u32x2*)orow + lane;
#pragma unroll
    for (int j = 0; j < 4; ++j) { const f32x4 gg = gr[64 * j]; u32x2 w; w.x = cvtpk(v[j].x * rs * gg.x, v[j].y * rs * gg.y); w.y = cvtpk(v[j].z * rs * gg.z, v[j].w * rs * gg.w); o8[64 * j] = w; }
}

__device__ __forceinline__ void p0_transpose_item(const float* W, int K, int N, bf16_t* WT, LAS float* scr, int item, int lane, const float* kgain = nullptr) {
    const int nblk = N / 32, kb = item / nblk, nb = item % nblk, k0 = 64 * kb, n0 = 32 * nb;
#pragma unroll 8
    for (int i = 0; i < 32; ++i) { const int kk = 2 * i + (lane >> 5); const float gk = kgain ? kgain[k0 + kk] : 1.0f; scr[kk * 33 + (lane & 31)] = W[(size_t)(k0 + kk) * N + n0 + (lane & 31)] * gk; }
    asm volatile("s_waitcnt lgkmcnt(0)" ::: "memory");
    const int c = lane & 7;
#pragma unroll
    for (int j = 0; j < 4; ++j) { const int n = (lane >> 3) + 8 * j; const LAS float* s = scr + (8 * c) * 33 + n;
        u32x4 o; o.x = cvtpk(s[0 * 33], s[1 * 33]); o.y = cvtpk(s[2 * 33], s[3 * 33]); o.z = cvtpk(s[4 * 33], s[5 * 33]); o.w = cvtpk(s[6 * 33], s[7 * 33]);
        *(u32x4*)(WT + (size_t)(n0 + n) * K + k0 + 8 * c) = o; }
    asm volatile("s_waitcnt lgkmcnt(0)" ::: "memory");
}

struct Ctx {
    LAS unsigned char* lds;
    int tid, lane, wave, vcu, G, gw, NGW;
    const float* const* in; float* out; unsigned char* ws;
};

__device__ __forceinline__ void phase_p0(const Ctx& F) {
    const float* w_in = F.in[2]; const float* w_out = F.in[6]; const float* wq = F.in[8]; const float* keys = F.in[9];
    const float* pu = F.in[10]; const float* pv = F.in[11];
    LAS float* scr = (LAS float*)(F.lds + F.wave * 16384);
    constexpr int I_IN = 16 * 72, I_SQ = 16 * 32, I_L = I_IN + 2 * I_SQ, NIT = 2 * I_L;
    for (int it = F.gw; it < NIT; it += F.NGW) {
        const int l = it / I_L, r = it % I_L;
        if (r < I_IN) p0_transpose_item(w_in + (size_t)l * DM * PW, DM, PW, (bf16_t*)(F.ws + WS_WIN) + (size_t)l * PW * DM, scr, r, F.lane);
        else if (r < I_IN + I_SQ) p0_transpose_item(w_out + (size_t)l * DM * DM, DM, DM, (bf16_t*)(F.ws + WS_WOUT) + (size_t)l * DM * DM, scr, r - I_IN, F.lane);
        else p0_transpose_item(wq + (size_t)l * DM * DM, DM, DM, (bf16_t*)(F.ws + WS_WQ) + (size_t)l * DM * DM, scr, r - I_IN - I_SQ, F.lane, F.in[7] + (size_t)l * DM);
    }
    const int gtid = F.vcu * NTHREADS + F.tid, NT = F.G * NTHREADS;
    for (int i = gtid; i < 262144 / 8; i += NT) {
        const f32x4 a = *(const f32x4*)(keys + (size_t)i * 8), b = *(const f32x4*)(keys + (size_t)i * 8 + 4);
        u32x4 o; o.x = cvtpk(a.x, a.y); o.y = cvtpk(a.z, a.w); o.z = cvtpk(b.x, b.y); o.w = cvtpk(b.z, b.w);
        *(u32x4*)((bf16_t*)(F.ws + WS_KEYS) + (size_t)i * 8) = o;
    }
#pragma unroll 2
    for (int rp = F.gw; rp < 2 * NEXP * 2 / 2; rp += F.NGW) {
        const int row = 2 * rp + (F.lane >> 5), k = F.lane & 31;
        const bool isv = row >= 2 * NEXP; const int rr = isv ? row - 2 * NEXP : row;
        const float* src = (isv ? pv : pu) + (size_t)rr * DM + 4 * k;
        f32x16 a, b;
#pragma unroll
        for (int i = 0; i < 8; ++i) { const f32x4 t = *(const f32x4*)(src + 128 * i); a[2 * i] = t.x; b[2 * i] = t.y; a[2 * i + 1] = t.z; b[2 * i + 1] = t.w; }
        float am = 0.f;
#pragma unroll
        for (int i = 0; i < 16; ++i) am = fmaxf(am, fmaxf(fabsf(a[i]), fabsf(b[i])));
        am = fmaxf(am, dppf<DPP_XOR1>(am)); am = fmaxf(am, dppf<DPP_XOR2>(am)); am = fmaxf(am, dppf<DPP_HMIR>(am)); am = fmaxf(am, dppf<DPP_RMIR>(am)); am = swap16_max(am);
        const float sc = am > 0.f ? exp2f(ceilf(log2f(am * (1.0f / 7.5f)))) : 1.0f, inv = 1.0f / sc;
        a = a * inv; b = b * inv;
        const u32x6 w = __builtin_amdgcn_cvt_scalef32_2xpk16_fp6_f32(a, b, 1.0f);
        *(u32x6_a8*)(F.ws + (isv ? WS_V : WS_U) + (size_t)rr * ROWB + 24 * k) = w;
        if (k == 0) ((float*)(F.ws + (isv ? WS_SV : WS_SU)))[rr] = sc;
    }
    for (int e = gtid; e < 2048 * 64; e += NT) {
        const int pos = e >> 6, i = e & 63;
        float ang;
        if (i < 32) ang = (float)pos * powf(10000.0f, -(float)i / 32.0f);
        else if (i < 48) ang = (float)(pos >> 6) * powf(10000.0f, -(float)(i - 32) / 16.0f);
        else ang = (float)(pos & 63) * powf(10000.0f, -(float)(i - 48) / 16.0f);
        f32x2_t cs; cs.x = cosf(ang); cs.y = sinf(ang);
        ((f32x2_t*)(F.ws + WS_ROPE))[e] = cs;
    }
    for (int m = F.gw; m < MTOK; m += 2 * F.NGW) {
        const int m2 = m + F.NGW;
        const f32x4* xa = (const f32x4*)(F.in[0] + (size_t)m * DM) + F.lane; const f32x4* xb = (const f32x4*)(F.in[0] + (size_t)(m2 < MTOK ? m2 : m) * DM) + F.lane;
        const f32x4* gr = (const f32x4*)F.in[1] + F.lane;
        f32x4 va[4], vb[4]; float sa = 0.f, sb = 0.f;
#pragma unroll
        for (int j = 0; j < 4; ++j) { va[j] = xa[64 * j]; vb[j] = xb[64 * j]; }
#pragma unroll
        for (int j = 0; j < 4; ++j) { sa += (va[j].x * va[j].x + va[j].y * va[j].y) + (va[j].z * va[j].z + va[j].w * va[j].w); sb += (vb[j].x * vb[j].x + vb[j].y * vb[j].y) + (vb[j].z * vb[j].z + vb[j].w * vb[j].w); }
        const float ra = rsqrtf(wave_sum(sa) * (1.0f / DM) + EPS), rb = rsqrtf(wave_sum(sb) * (1.0f / DM) + EPS);
        u32x2* oa = (u32x2*)((bf16_t*)(F.ws + WS_H) + (size_t)m * DM) + F.lane; u32x2* ob = (u32x2*)((bf16_t*)(F.ws + WS_H) + (size_t)(m2 < MTOK ? m2 : m) * DM) + F.lane;
#pragma unroll
        for (int j = 0; j < 4; ++j) { const f32x4 gg = gr[64 * j];
            u32x2 w; w.x = cvtpk(va[j].x * ra * gg.x, va[j].y * ra * gg.y); w.y = cvtpk(va[j].z * ra * gg.z, va[j].w * ra * gg.w); oa[64 * j] = w;
            if (m2 < MTOK) { u32x2 v; v.x = cvtpk(vb[j].x * rb * gg.x, vb[j].y * rb * gg.y); v.y = cvtpk(vb[j].z * rb * gg.z, vb[j].w * rb * gg.w); ob[64 * j] = v; } }
    }
}

__device__ __forceinline__ void phase_norm(const Ctx& F, const float* x, const float* g) {
    for (int m = F.gw; m < MTOK; m += F.NGW) norm_row_to_bf16(x + (size_t)m * DM, g, (bf16_t*)(F.ws + WS_H) + (size_t)m * DM, F.lane);
}

__device__ __forceinline__ void head_info(int hs, int& type, int& gi) {
    if (hs < 6) { type = 1; gi = 0; } else if (hs < 8) { type = 1; gi = 1; } else if (hs < 10) { type = 0; gi = 0; }
    else if (hs < 16) { type = 2; gi = 2; } else if (hs < 22) { type = 2; gi = 3; } else if (hs < 28) { type = 0; gi = 0; }
    else if (hs < 32) { type = 2; gi = 4; } else if (hs < 34) { type = 2; gi = 5; } else { type = 0; gi = 0; }
}
__device__ __forceinline__ void phase_rope(const Ctx& F, const float* gain  ) {
    bf16_t* P = (bf16_t*)(F.ws + WS_P);
    const f32x2_t* tab = (const f32x2_t*)(F.ws + WS_ROPE);
    const int s = F.lane & 7, grp8 = F.lane >> 3;
#pragma unroll 2
    for (int tok = F.gw; tok < MTOK; tok += F.NGW) {
        const int pos = tok & (SEQ - 1);
        bf16_t* row = P + (size_t)tok * PW;
#pragma unroll 1
        for (int pass = 0; pass < 2; ++pass) {
            const int hs = pass == 0 ? (grp8 < 2 ? 6 + grp8 : 14 + grp8) : (grp8 < 2 ? 32 + grp8 : 33);
            const bool act = pass == 0 || grp8 < 2;
            int type, gi; head_info(hs, type, gi);
            const u32x4 raw = *(const u32x4*)(row + hs * 64 + s * 8);
            float x[8]; x[0] = bf_lo(raw.x); x[1] = bf_hi(raw.x); x[2] = bf_lo(raw.y); x[3] = bf_hi(raw.y); x[4] = bf_lo(raw.z); x[5] = bf_hi(raw.z); x[6] = bf_lo(raw.w); x[7] = bf_hi(raw.w);
            float ss = 0.f;
#pragma unroll
            for (int e = 0; e < 8; ++e) ss += x[e] * x[e];
            ss += dppf<DPP_XOR1>(ss); ss += dppf<DPP_XOR2>(ss); ss += dppf<DPP_HMIR>(ss);
            const float rs = rsqrtf(ss * (1.0f / 64.0f) + EPS);
            const f32x4 g0 = *(const f32x4*)(gain + gi * 64 + s * 8), g1 = *(const f32x4*)(gain + gi * 64 + s * 8 + 4);
            float y[8]; y[0] = x[0] * rs * g0.x; y[1] = x[1] * rs * g0.y; y[2] = x[2] * rs * g0.z; y[3] = x[3] * rs * g0.w; y[4] = x[4] * rs * g1.x; y[5] = x[5] * rs * g1.y; y[6] = x[6] * rs * g1.z; y[7] = x[7] * rs * g1.w;
            const bool one_d = (type == 2);
            const int tbase = one_d ? 8 * (s & 3) : 32 + (s >> 2) * 16 + 8 * (s & 1);
            const bool isx1 = one_d ? (s < 4) : ((s & 2) == 0);
            float o[8];
#pragma unroll
            for (int e = 0; e < 8; ++e) {
                const float o4 = dppf<DPP_HMIR>(dppf<DPP_XOR3>(y[e])), o2 = dppf<DPP_XOR2>(y[e]);
                const float oth = one_d ? o4 : o2;
                const f32x2_t cs = tab[pos * 64 + tbase + e];
                o[e] = isx1 ? (y[e] * cs.x - oth * cs.y) : (oth * cs.y + y[e] * cs.x);
            }
            if (act) {
                u32x4 w; w.x = cvtpk(o[0], o[1]); w.y = cvtpk(o[2], o[3]); w.z = cvtpk(o[4], o[5]); w.w = cvtpk(o[6], o[7]);
                *(u32x4*)(row + hs * 64 + s * 8) = w;
            }
        }
    }
}

struct AUnit {
    const bf16_t* q; const bf16_t* k; const bf16_t* v;
    bf16_t* o; float* lse;
    int ostride, btok, r, c, pair, pos0, T0, T1, W, has_sink; float sink2;
    const float* qgain; const f32x2_t* ropetab; int qaxial;
};
constexpr int ATT_KV = 0, ATT_WSF = 32768, ATT_OST = 34816;

__device__ __forceinline__ void attn_unit(const AUnit& U, LAS unsigned char* lds, int tid) {
    const int lane = tid & 63, r32 = lane & 31, hi = lane >> 5; const int wid = __builtin_amdgcn_readfirstlane(tid >> 6);
    const int sub = U.pair ? (wid >> 2) : 0;
    const int ipos0 = U.pair ? 32 * (wid & 3) : U.pos0 + 32 * wid;
    const int myi = ipos0 + r32;
    const int tokq0 = U.btok + U.c + sub;
    int wt0, wt1;
    if (U.pair) { wt0 = 2 * sub; wt1 = wt0 + 2; }
    else if (U.W >= 0) { wt0 = max(U.T0, (ipos0 - U.W) >> 6); wt1 = min(U.T1, ((ipos0 + 31 + U.W) >> 6) + 1); }
    else { wt0 = U.T0; wt1 = U.T1; }
    const int vkey = 16 * (wid & 3) + (lane >> 2);
    const int kcol = wid * 8, vcol = (wid >> 2) * 32 + (lane & 3) * 8;
    const unsigned stoff = (unsigned)wid * 1024u + (unsigned)lane * 16u;
#define ATT_TOK(t, key) (U.pair ? (U.btok + U.c + ((t) >> 1) + (64 * ((t) & 1) + (key)) * 16) : (U.btok + U.c + (64 * (t) + (key)) * U.r))
    LAS float* wsf = (LAS float*)(lds + ATT_WSF) + wid * 64;
    float m = U.has_sink ? U.sink2 : 0.f;
    bool started = U.has_sink != 0;
    f32x16 negm;
#pragma unroll
    for (int r = 0; r < 16; ++r) negm[r] = -m;
    float l = (U.has_sink && hi == 0) ? 1.0f : 0.0f;
    f32x16 o0 = {}, o1 = {};
    u32x4 kA, vA, kB, vB;
#define ATT_LD(KR, VR, tt) do { const int t__ = min((tt), U.T1 - 1); KR = *(const u32x4*)(U.k + (size_t)ATT_TOK(t__, lane) * PW + kcol); VR = *(const u32x4*)(U.v + (size_t)ATT_TOK(t__, vkey) * PW + vcol); } while (0)
#define ATT_ST(bufi, KR, VR) do { *(LAS u32x4*)(lds + ATT_KV + (bufi) * 16384 + stoff) = KR; *(LAS u32x4*)(lds + ATT_KV + (bufi) * 16384 + 8192 + stoff) = VR; } while (0)
    ATT_LD(kA, vA, U.T0);
    bf16x8 qr[4];
    {   const int qtok = tokq0 + myi * U.r, pos = qtok & (SEQ - 1);
        const bf16_t* qp = U.q + (size_t)qtok * PW + hi * 8;
        float y[4][8]; float ss = 0.f;
#pragma unroll
        for (int d0 = 0; d0 < 4; ++d0) { const u32x4 raw = *(const u32x4*)(qp + d0 * 16);
            y[d0][0] = bf_lo(raw.x); y[d0][1] = bf_hi(raw.x); y[d0][2] = bf_lo(raw.y); y[d0][3] = bf_hi(raw.y); y[d0][4] = bf_lo(raw.z); y[d0][5] = bf_hi(raw.z); y[d0][6] = bf_lo(raw.w); y[d0][7] = bf_hi(raw.w);
#pragma unroll
            for (int j = 0; j < 8; ++j) ss += y[d0][j] * y[d0][j]; }
        ss = swap32_sum(ss, ss);
        const float rs = rsqrtf(ss * (1.0f / 64.0f) + EPS);
#pragma unroll
        for (int d0 = 0; d0 < 4; ++d0) { const f32x4 g0 = *(const f32x4*)(U.qgain + d0 * 16 + hi * 8), g1 = *(const f32x4*)(U.qgain + d0 * 16 + hi * 8 + 4);
            y[d0][0] *= rs * g0.x; y[d0][1] *= rs * g0.y; y[d0][2] *= rs * g0.z; y[d0][3] *= rs * g0.w; y[d0][4] *= rs * g1.x; y[d0][5] *= rs * g1.y; y[d0][6] *= rs * g1.z; y[d0][7] *= rs * g1.w; }
        const f32x2_t* tab = U.ropetab + (size_t)pos * 64;
        float z[4][8];
        if (U.qaxial) {
#pragma unroll
            for (int hf2 = 0; hf2 < 2; ++hf2)
#pragma unroll
                for (int j = 0; j < 8; ++j) { const f32x2_t cs = tab[32 + hf2 * 16 + 8 * hi + j]; const float x1 = y[2 * hf2][j], x2 = y[2 * hf2 + 1][j];
                    z[2 * hf2][j] = x1 * cs.x - x2 * cs.y; z[2 * hf2 + 1][j] = x1 * cs.y + x2 * cs.x; }
        } else {
#pragma unroll
            for (int d0 = 0; d0 < 2; ++d0)
#pragma unroll
                for (int j = 0; j < 8; ++j) { const f32x2_t cs = tab[16 * d0 + 8 * hi + j]; const float x1 = y[d0][j], x2 = y[d0 + 2][j];
                    z[d0][j] = x1 * cs.x - x2 * cs.y; z[d0 + 2][j] = x1 * cs.y + x2 * cs.x; }
        }
#pragma unroll
        for (int d0 = 0; d0 < 4; ++d0) { u32x4 w; w.x = cvtpk(z[d0][0] * QSCALE, z[d0][1] * QSCALE); w.y = cvtpk(z[d0][2] * QSCALE, z[d0][3] * QSCALE); w.z = cvtpk(z[d0][4] * QSCALE, z[d0][5] * QSCALE); w.w = cvtpk(z[d0][6] * QSCALE, z[d0][7] * QSCALE);
            qr[d0] = __builtin_bit_cast(bf16x8, w); }
    }
    ATT_ST(0, kA, vA);
    __syncthreads();
    ATT_LD(kA, vA, U.T0 + 1);
    for (int t = U.T0; t < U.T1; t += 2) {
        ATT_LD(kB, vB, t + 2);
        { const int TT = t; constexpr int CUR = 0;
        if (TT >= wt0 && TT < wt1) {
            LAS const unsigned char* kb = lds + ATT_KV + CUR * 16384 + hi * 1024 + r32 * 16;
            LAS const unsigned char* vp = lds + ATT_KV + CUR * 16384 + 8192 + ((lane >> 4) & 1) * 32 + (lane & 3) * 8 + (4 * hi + ((lane & 15) >> 2)) * 64;
            bf16x8 kf[8];
#pragma unroll
            for (int d0 = 0; d0 < 4; ++d0) { kf[2 * d0] = *(LAS const bf16x8*)(kb + d0 * 2048); kf[2 * d0 + 1] = *(LAS const bf16x8*)(kb + d0 * 2048 + 512); }
            s16x4 vlo[8], vhi[8];
#define ATT_TR(off) __builtin_bit_cast(s16x4, __builtin_amdgcn_ds_read_tr16_b64_v4i16((LAS s16x4*)(vp + (off))))
#pragma unroll
            for (int i = 0; i < 8; ++i) { vlo[i] = ATT_TR((i >> 2) * 4096 + (i & 3) * 1024); vhi[i] = ATT_TR((i >> 2) * 4096 + (i & 3) * 1024 + 512); }
#undef ATT_TR
            f32x16 p0 = negm, p1 = negm;
#pragma unroll
            for (int d0 = 0; d0 < 4; ++d0) {
                p0 = __builtin_amdgcn_mfma_f32_32x32x16_bf16(kf[2 * d0], qr[d0], p0, 0, 0, 0);
                p1 = __builtin_amdgcn_mfma_f32_32x32x16_bf16(kf[2 * d0 + 1], qr[d0], p1, 0, 0, 0);
            }
            if (U.W >= 0) {
                const int jb = (U.pair ? 64 * (TT & 1) : 64 * TT) + 4 * hi;
                const int lo = myi - U.W - jb; const unsigned span = 2u * (unsigned)U.W;
#pragma unroll
                for (int r = 0; r < 16; ++r) {
                    const int jr = (r & 3) + 8 * (r >> 2);
                    if ((unsigned)(jr - lo) > span) p0[r] = -INFINITY;
                    if ((unsigned)(jr + 32 - lo) > span) p1[r] = -INFINITY;
                }
            }
            float mx = fmaxf(p0[0], p1[0]);
#pragma unroll
            for (int r = 1; r < 16; ++r) mx = fmax3(mx, p0[r], p1[r]);
            { auto rr = __builtin_amdgcn_permlane32_swap(__float_as_uint(mx), __float_as_uint(mx), false, false); mx = fmaxf(__uint_as_float(rr[0]), __uint_as_float(rr[1])); }
            if (!started || __any(mx > 8.0f)) {
                float dl = started ? fmaxf(mx, 0.f) : mx;
                if (dl == -INFINITY) dl = 0.f;
                m += dl;
#pragma unroll
                for (int r = 0; r < 16; ++r) { p0[r] -= dl; p1[r] -= dl; negm[r] = -m; }
                if (started) {
                    const float alpha = __builtin_amdgcn_exp2f(-dl);
                    l *= alpha;
                    if (hi == 0) wsf[r32] = alpha;
#pragma unroll
                    for (int r = 0; r < 16; ++r) { const float a = wsf[crow(r, hi)]; o0[r] *= a; o1[r] *= a; }
                }
                started = true;
            }
            float rsum = 0.f;
#pragma unroll
            for (int r = 0; r < 16; ++r) { p0[r] = __builtin_amdgcn_exp2f(p0[r]); p1[r] = __builtin_amdgcn_exp2f(p1[r]); rsum += p0[r] + p1[r]; }
            l += rsum;
            u32x4 pw0, pw1, pw2, pw3;
            pw0.x = cvtpk(p0[0], p0[1]); pw0.y = cvtpk(p0[2], p0[3]); pw0.z = cvtpk(p0[4], p0[5]); pw0.w = cvtpk(p0[6], p0[7]);
            pw1.x = cvtpk(p0[8], p0[9]); pw1.y = cvtpk(p0[10], p0[11]); pw1.z = cvtpk(p0[12], p0[13]); pw1.w = cvtpk(p0[14], p0[15]);
            pw2.x = cvtpk(p1[0], p1[1]); pw2.y = cvtpk(p1[2], p1[3]); pw2.z = cvtpk(p1[4], p1[5]); pw2.w = cvtpk(p1[6], p1[7]);
            pw3.x = cvtpk(p1[8], p1[9]); pw3.y = cvtpk(p1[10], p1[11]); pw3.z = cvtpk(p1[12], p1[13]); pw3.w = cvtpk(p1[14], p1[15]);
#define ATT_VF(i) (bf16x8){vlo[i][0], vlo[i][1], vlo[i][2], vlo[i][3], vhi[i][0], vhi[i][1], vhi[i][2], vhi[i][3]}
            o0 = __builtin_amdgcn_mfma_f32_32x32x16_bf16(__builtin_bit_cast(bf16x8, pw0), ATT_VF(0), o0, 0, 0, 0);
            o1 = __builtin_amdgcn_mfma_f32_32x32x16_bf16(__builtin_bit_cast(bf16x8, pw0), ATT_VF(4), o1, 0, 0, 0);
            o0 = __builtin_amdgcn_mfma_f32_32x32x16_bf16(__builtin_bit_cast(bf16x8, pw1), ATT_VF(1), o0, 0, 0, 0);
            o1 = __builtin_amdgcn_mfma_f32_32x32x16_bf16(__builtin_bit_cast(bf16x8, pw1), ATT_VF(5), o1, 0, 0, 0);
            o0 = __builtin_amdgcn_mfma_f32_32x32x16_bf16(__builtin_bit_cast(bf16x8, pw2), ATT_VF(2), o0, 0, 0, 0);
            o1 = __builtin_amdgcn_mfma_f32_32x32x16_bf16(__builtin_bit_cast(bf16x8, pw2), ATT_VF(6), o1, 0, 0, 0);
            o0 = __builtin_amdgcn_mfma_f32_32x32x16_bf16(__builtin_bit_cast(bf16x8, pw3), ATT_VF(3), o0, 0, 0, 0);
            o1 = __builtin_amdgcn_mfma_f32_32x32x16_bf16(__builtin_bit_cast(bf16x8, pw3), ATT_VF(7), o1, 0, 0, 0);
#undef ATT_VF
        }
        }
        if (t + 1 < U.T1) ATT_ST(1, kA, vA);
        __syncthreads();
        if (t + 1 >= U.T1) break;
        ATT_LD(kA, vA, t + 3);
        { const int TT = t + 1; constexpr int CUR = 1;
        if (TT >= wt0 && TT < wt1) {
            LAS const unsigned char* kb = lds + ATT_KV + CUR * 16384 + hi * 1024 + r32 * 16;
            LAS const unsigned char* vp = lds + ATT_KV + CUR * 16384 + 8192 + ((lane >> 4) & 1) * 32 + (lane & 3) * 8 + (4 * hi + ((lane & 15) >> 2)) * 64;
            bf16x8 kf[8];
#pragma unroll
            for (int d0 = 0; d0 < 4; ++d0) { kf[2 * d0] = *(LAS const bf16x8*)(kb + d0 * 2048); kf[2 * d0 + 1] = *(LAS const bf16x8*)(kb + d0 * 2048 + 512); }
            s16x4 vlo[8], vhi[8];
#define ATT_TR(off) __builtin_bit_cast(s16x4, __builtin_amdgcn_ds_read_tr16_b64_v4i16((LAS s16x4*)(vp + (off))))
#pragma unroll
            for (int i = 0; i < 8; ++i) { vlo[i] = ATT_TR((i >> 2) * 4096 + (i & 3) * 1024); vhi[i] = ATT_TR((i >> 2) * 4096 + (i & 3) * 1024 + 512); }
#undef ATT_TR
            f32x16 p0 = negm, p1 = negm;
#pragma unroll
            for (int d0 = 0; d0 < 4; ++d0) {
                p0 = __builtin_amdgcn_mfma_f32_32x32x16_bf16(kf[2 * d0], qr[d0], p0, 0, 0, 0);
                p1 = __builtin_amdgcn_mfma_f32_32x32x16_bf16(kf[2 * d0 + 1], qr[d0], p1, 0, 0, 0);
            }
            if (U.W >= 0) {
                const int jb = (U.pair ? 64 * (TT & 1) : 64 * TT) + 4 * hi;
                const int lo = myi - U.W - jb; const unsigned span = 2u * (unsigned)U.W;
#pragma unroll
                for (int r = 0; r < 16; ++r) {
                    const int jr = (r & 3) + 8 * (r >> 2);
                    if ((unsigned)(jr - lo) > span) p0[r] = -INFINITY;
                    if ((unsigned)(jr + 32 - lo) > span) p1[r] = -INFINITY;
                }
            }
            float mx = fmaxf(p0[0], p1[0]);
#pragma unroll
            for (int r = 1; r < 16; ++r) mx = fmax3(mx, p0[r], p1[r]);
            { auto rr = __builtin_amdgcn_permlane32_swap(__float_as_uint(mx), __float_as_uint(mx), false, false); mx = fmaxf(__uint_as_float(rr[0]), __uint_as_float(rr[1])); }
            if (!started || __any(mx > 8.0f)) {
                float dl = started ? fmaxf(mx, 0.f) : mx;
                if (dl == -INFINITY) dl = 0.f;
                m += dl;
#pragma unroll
                for (int r = 0; r < 16; ++r) { p0[r] -= dl; p1[r] -= dl; negm[r] = -m; }
                if (started) {
                    const float alpha = __builtin_amdgcn_exp2f(-dl);
                    l *= alpha;
                    if (hi == 0) wsf[r32] = alpha;
#pragma unroll
                    for (int r = 0; r < 16; ++r) { const float a = wsf[crow(r, hi)]; o0[r] *= a; o1[r] *= a; }
                }
                started = true;
            }
            float rsum = 0.f;
#pragma unroll
            for (int r = 0; r < 16; ++r) { p0[r] = __builtin_amdgcn_exp2f(p0[r]); p1[r] = __builtin_amdgcn_exp2f(p1[r]); rsum += p0[r] + p1[r]; }
            l += rsum;
            u32x4 pw0, pw1, pw2, pw3;
            pw0.x = cvtpk(p0[0], p0[1]); pw0.y = cvtpk(p0[2], p0[3]); pw0.z = cvtpk(p0[4], p0[5]); pw0.w = cvtpk(p0[6], p0[7]);
            pw1.x = cvtpk(p0[8], p0[9]); pw1.y = cvtpk(p0[10], p0[11]); pw1.z = cvtpk(p0[12], p0[13]); pw1.w = cvtpk(p0[14], p0[15]);
            pw2.x = cvtpk(p1[0], p1[1]); pw2.y = cvtpk(p1[2], p1[3]); pw2.z = cvtpk(p1[4], p1[5]); pw2.w = cvtpk(p1[6], p1[7]);
            pw3.x = cvtpk(p1[8], p1[9]); pw3.y = cvtpk(p1[10], p1[11]); pw3.z = cvtpk(p1[12], p1[13]); pw3.w = cvtpk(p1[14], p1[15]);
#define ATT_VF(i) (bf16x8){vlo[i][0], vlo[i][1], vlo[i][2], vlo[i][3], vhi[i][0], vhi[i][1], vhi[i][2], vhi[i][3]}
            o0 = __builtin_amdgcn_mfma_f32_32x32x16_bf16(__builtin_bit_cast(bf16x8, pw0), ATT_VF(0), o0, 0, 0, 0);
            o1 = __builtin_amdgcn_mfma_f32_32x32x16_bf16(__builtin_bit_cast(bf16x8, pw0), ATT_VF(4), o1, 0, 0, 0);
            o0 = __builtin_amdgcn_mfma_f32_32x32x16_bf16(__builtin_bit_cast(bf16x8, pw1), ATT_VF(1), o0, 0, 0, 0);
            o1 = __builtin_amdgcn_mfma_f32_32x32x16_bf16(__builtin_bit_cast(bf16x8, pw1), ATT_VF(5), o1, 0, 0, 0);
            o0 = __builtin_amdgcn_mfma_f32_32x32x16_bf16(__builtin_bit_cast(bf16x8, pw2), ATT_VF(2), o0, 0, 0, 0);
            o1 = __builtin_amdgcn_mfma_f32_32x32x16_bf16(__builtin_bit_cast(bf16x8, pw2), ATT_VF(6), o1, 0, 0, 0);
            o0 = __builtin_amdgcn_mfma_f32_32x32x16_bf16(__builtin_bit_cast(bf16x8, pw3), ATT_VF(3), o0, 0, 0, 0);
            o1 = __builtin_amdgcn_mfma_f32_32x32x16_bf16(__builtin_bit_cast(bf16x8, pw3), ATT_VF(7), o1, 0, 0, 0);
#undef ATT_VF
        }
        }
        if (t + 2 < U.T1) ATT_ST(0, kB, vB);
        __syncthreads();
    }
#undef ATT_LD
#undef ATT_ST
#undef ATT_TOK
    float ltot;
    { auto rr = __builtin_amdgcn_permlane32_swap(__float_as_uint(l), __float_as_uint(l), false, false); ltot = __uint_as_float(rr[0]) + __uint_as_float(rr[1]); }
    if (hi == 0) wsf[r32] = 1.0f / ltot;
    LAS bf16_t* stg = (LAS bf16_t*)(lds + ATT_OST) + wid * 2048;
#pragma unroll
    for (int r = 0; r < 16; ++r) {
        const int orow = crow(r, hi); const float rl = wsf[orow];
        stg[orow * 64 + r32] = (bf16_t)(cvtpk(o0[r] * rl, 0.f) & 0xffffu);
        stg[orow * 64 + 32 + r32] = (bf16_t)(cvtpk(o1[r] * rl, 0.f) & 0xffffu);
    }
#pragma unroll
    for (int i = 0; i < 4; ++i) {
        const int row = i * 8 + (lane >> 3), ch = lane & 7;
        const u32x4 v = *(LAS const u32x4*)(stg + row * 64 + ch * 8);
        *(u32x4*)(U.o + (size_t)(tokq0 + (ipos0 + row) * U.r) * U.ostride + ch * 8) = v;
    }
    if (U.lse != nullptr && hi == 0) U.lse[(size_t)(tokq0 + myi * U.r) * 6] = m + __builtin_amdgcn_logf(ltot);
}

__device__ __forceinline__ void phase_attn(const Ctx& F, const float* sink  , const float* gain  ) {
    const bf16_t* P = (const bf16_t*)(F.ws + WS_P);
    bf16_t* MIX = (bf16_t*)(F.ws + WS_MIX); bf16_t* OB = (bf16_t*)(F.ws + WS_OB); float* LSE = (float*)(F.ws + WS_LSE);
    constexpr int NU = 768 * 4 + 512;
    for (int u = F.vcu; u < NU; u += F.G) {
        AUnit U; U.lse = nullptr; U.r = 1; U.c = 0; U.pair = 0; U.W = -1; U.has_sink = 0; U.sink2 = 0.f; U.ropetab = (const f32x2_t*)(F.ws + WS_ROPE);
        if (u < 768) {
            const int b = u / 48, h = (u >> 3) % 6, qb = u & 7;
            U.q = P + C_QA + h * 64; U.k = P + C_KA + (h / 3) * 64; U.v = P + C_VA + (h / 3) * 64; U.o = MIX + h * 64; U.ostride = DM;
            U.btok = b * SEQ; U.pos0 = 256 * qb; U.T0 = 0; U.T1 = 32; U.qgain = gain; U.qaxial = 1;
        } else if (u < 3072) {
            const int br = (u - 768) / 768, uu = (u - 768) % 768;
            const int b = uu / 48, h = (uu >> 3) % 6, x = uu & 7;
            U.q = P + C_QB + h * 64; U.k = P + C_KB + h * 64; U.v = P + C_VB + h * 64; U.o = OB + (size_t)br * MTOK * 384 + h * 64; U.ostride = 384;
            U.lse = LSE + (size_t)br * MTOK * 6 + h; U.btok = b * SEQ; U.W = 64; U.qgain = gain + 2 * 64; U.qaxial = 0;
            if (br == 0) { U.pos0 = 256 * x; U.T0 = max(0, 4 * x - 1); U.T1 = min(32, 4 * x + 5); }
            else if (br == 1) { const int qb = x & 1; U.r = 4; U.c = x >> 1; U.pos0 = 256 * qb; U.T0 = max(0, 4 * qb - 1); U.T1 = min(8, 4 * qb + 5); }
            else { U.r = 16; U.c = 2 * x; U.pair = 1; U.pos0 = 0; U.T0 = 0; U.T1 = 4; }
        } else {
            const int uu = u - 3072; const int b = uu / 32, h = (uu >> 3) & 3, qb = uu & 7;
            U.q = P + C_QC + h * 64; U.k = P + C_KC + (h >> 1) * 64; U.v = P + C_VC + (h >> 1) * 64; U.o = MIX + 768 + h * 64; U.ostride = DM;
            U.btok = b * SEQ; U.pos0 = 256 * qb; U.W = 128; U.T0 = max(0, 4 * qb - 2); U.T1 = min(32, 4 * qb + 6);
            U.has_sink = 1; U.sink2 = sink[h] * LOG2E; U.qgain = gain + 4 * 64; U.qaxial = 0;
        }
        attn_unit(U, F.lds, F.tid);
    }
}

__device__ __forceinline__ void unpack8(const u32x4 w, float (&x)[8]) { x[0] = bf_lo(w.x); x[1] = bf_hi(w.x); x[2] = bf_lo(w.y); x[3] = bf_hi(w.y); x[4] = bf_lo(w.z); x[5] = bf_hi(w.z); x[6] = bf_lo(w.w); x[7] = bf_hi(w.w); }
struct PostRaw { u32x4 a, c, t0, t1, t2; float ls0, ls1, ls2; };
__device__ __forceinline__ void post_load(PostRaw& R, const bf16_t* MIX, const bf16_t* OB, const float* LSE, int tok, int l48, int l32) {
    R.a = *(const u32x4*)(MIX + (size_t)tok * DM + l48 * 8); R.c = *(const u32x4*)(MIX + (size_t)tok * DM + 768 + l32 * 8);
    const int h = l48 >> 3;
    R.ls0 = LSE[(size_t)tok * 6 + h]; R.ls1 = LSE[(size_t)(MTOK + tok) * 6 + h]; R.ls2 = LSE[(size_t)(2 * MTOK + tok) * 6 + h];
    R.t0 = *(const u32x4*)(OB + (size_t)tok * 384 + l48 * 8); R.t1 = *(const u32x4*)(OB + (size_t)(MTOK + tok) * 384 + l48 * 8); R.t2 = *(const u32x4*)(OB + (size_t)(2 * MTOK + tok) * 384 + l48 * 8);
}
__device__ __forceinline__ void phase_post(const Ctx& F, const float* g  ) {
    const bf16_t* MIX = (const bf16_t*)(F.ws + WS_MIX); const bf16_t* OB = (const bf16_t*)(F.ws + WS_OB); const float* LSE = (const float*)(F.ws + WS_LSE);
    bf16_t* H = (bf16_t*)(F.ws + WS_H);
    const int lane = F.lane; const int l48 = lane < 48 ? lane : 47, l32 = lane < 32 ? lane : 31;
    if (F.gw >= MTOK) return;
    PostRaw R; post_load(R, MIX, OB, LSE, F.gw, l48, l32);
    for (int tok = F.gw; tok < MTOK; tok += F.NGW) {
        PostRaw N; const int tn = tok + F.NGW;
        post_load(N, MIX, OB, LSE, tn < MTOK ? tn : tok, l48, l32);
        float a[8], bsum[8], c[8];
        unpack8(R.a, a); unpack8(R.c, c);
        const float mxl = fmax3(R.ls0, R.ls1, R.ls2);
        float w0 = __builtin_amdgcn_exp2f(R.ls0 - mxl), w1 = __builtin_amdgcn_exp2f(R.ls1 - mxl), w2 = __builtin_amdgcn_exp2f(R.ls2 - mxl);
        const float inv = 1.0f / (w0 + w1 + w2); w0 *= inv; w1 *= inv; w2 *= inv;
        { float t0[8], t1[8], t2[8];
          unpack8(R.t0, t0); unpack8(R.t1, t1); unpack8(R.t2, t2);
#pragma unroll
          for (int e = 0; e < 8; ++e) bsum[e] = w0 * t0[e] + w1 * t1[e] + w2 * t2[e]; }
        float sa = 0.f, sb = 0.f, sc = 0.f;
#pragma unroll
        for (int e = 0; e < 8; ++e) { sa += a[e] * a[e]; sb += bsum[e] * bsum[e]; sc += c[e] * c[e]; }
        if (lane >= 48) { sa = 0.f; sb = 0.f; }
        if (lane >= 32) sc = 0.f;
        sa = wave_sum(sa); sb = wave_sum(sb); sc = wave_sum(sc);
        const float ra = rsqrtf(sa * (1.0f / 384.0f) + EPS), rb = rsqrtf(sb * (1.0f / 384.0f) + EPS), rc = rsqrtf(sc * (1.0f / 256.0f) + EPS);
        if (lane < 48) {
            const f32x4 g0 = *(const f32x4*)(g + lane * 8), g1 = *(const f32x4*)(g + lane * 8 + 4);
            u32x4 w; w.x = cvtpk(a[0] * ra * g0.x, a[1] * ra * g0.y); w.y = cvtpk(a[2] * ra * g0.z, a[3] * ra * g0.w); w.z = cvtpk(a[4] * ra * g1.x, a[5] * ra * g1.y); w.w = cvtpk(a[6] * ra * g1.z, a[7] * ra * g1.w);
            *(u32x4*)(H + (size_t)tok * DM + lane * 8) = w;
            const f32x4 h0 = *(const f32x4*)(g + 384 + lane * 8), h1 = *(const f32x4*)(g + 384 + lane * 8 + 4);
            u32x4 v; v.x = cvtpk(bsum[0] * rb * h0.x, bsum[1] * rb * h0.y); v.y = cvtpk(bsum[2] * rb * h0.z, bsum[3] * rb * h0.w); v.z = cvtpk(bsum[4] * rb * h1.x, bsum[5] * rb * h1.y); v.w = cvtpk(bsum[6] * rb * h1.z, bsum[7] * rb * h1.w);
            *(u32x4*)(H + (size_t)tok * DM + 384 + lane * 8) = v;
        }
        if (lane < 32) {
            const f32x4 g0 = *(const f32x4*)(g + 768 + lane * 8), g1 = *(const f32x4*)(g + 768 + lane * 8 + 4);
            u32x4 w; w.x = cvtpk(c[0] * rc * g0.x, c[1] * rc * g0.y); w.y = cvtpk(c[2] * rc * g0.z, c[3] * rc * g0.w); w.z = cvtpk(c[4] * rc * g1.x, c[5] * rc * g1.y); w.w = cvtpk(c[6] * rc * g1.z, c[7] * rc * g1.w);
            *(u32x4*)(H + (size_t)tok * DM + 768 + lane * 8) = w;
        }
        R = N;
    }
}

__device__ __forceinline__ float vmaxr(float a, float b) { float r; asm("v_max_f32_e32 %0, %1, %2" : "=v"(r) : "v"(a), "v"(b)); return r; }
__device__ __forceinline__ float vminr(float a, float b) { float r; asm("v_min_f32_e32 %0, %1, %2" : "=v"(r) : "v"(a), "v"(b)); return r; }
#define CEX_D(a, b) do { const float hi_ = vmaxr(a, b), lo_ = vminr(a, b); a = hi_; b = lo_; } while (0)
template <int N> __device__ __forceinline__ void bitonic_sort_desc(float (&v)[N]) {
#pragma unroll
    for (int k = 2; k <= N; k <<= 1)
#pragma unroll
        for (int j = k >> 1; j > 0; j >>= 1)
#pragma unroll
            for (int i = 0; i < N; ++i) { const int l = i ^ j; if (l > i) { if ((i & k) == 0) CEX_D(v[i], v[l]); else CEX_D(v[l], v[i]); } }
}
__device__ __forceinline__ void bitonic_merge16_desc(float (&v)[16]) {
#pragma unroll
    for (int j = 8; j > 0; j >>= 1)
#pragma unroll
        for (int i = 0; i < 16; ++i) { const int l = i ^ j; if (l > i) CEX_D(v[i], v[l]); }
}
template <bool SWAP16> __device__ __forceinline__ void merge_partner16(float (&a)[16]) {
    float e[16], o[16];
#pragma unroll
    for (int i = 0; i < 16; ++i) {
        if (SWAP16) { auto r = __builtin_amdgcn_permlane16_swap(__float_as_uint(a[i]), __float_as_uint(a[i]), false, false); e[i] = __uint_as_float(r[0]); o[i] = __uint_as_float(r[1]); }
        else { auto r = __builtin_amdgcn_permlane32_swap(__float_as_uint(a[i]), __float_as_uint(a[i]), false, false); e[i] = __uint_as_float(r[0]); o[i] = __uint_as_float(r[1]); }
    }
#pragma unroll
    for (int i = 0; i < 16; ++i) a[i] = vmaxr(e[i], o[15 - i]);
    bitonic_merge16_desc(a);
}
__device__ __forceinline__ void phase_route(const Ctx& F, int layer) {
    const bf16_t* Q = (const bf16_t*)(F.ws + WS_Q);
    const bf16_t* KEYS = (const bf16_t*)(F.ws + WS_KEYS) + (size_t)layer * 8 * 2 * 128 * 64;
    unsigned short* IDX = (unsigned short*)(F.ws + WS_IDX); float* GATE = (float*)(F.ws + WS_GATE);
    const float* SSQ = (const float*)(F.ws + WS_SSQ) + (size_t)layer * MTOK * 16;
    const int lane = F.lane, c = lane & 15, g = lane >> 4;
    const int krow = F.wave * 16 + (lane >> 3), kch = lane & 7;
    const unsigned kw0 = (unsigned)krow * 128u + (unsigned)((kch ^ ((krow >> 1) & 7)) << 4), kw1 = (unsigned)(krow + 8) * 128u + (unsigned)((kch ^ (((krow + 8) >> 1) & 7)) << 4);
    const unsigned kra = (unsigned)c * 128u, ksw = (unsigned)((c >> 1) & 7);
    for (int ub = F.vcu * NWAVES; ub < MTOK / 16; ub += F.NGW) {
        const int unit = ub + F.wave;
        const int tok = unit * 16 + c;
        const bf16_t* qrow = Q + (size_t)tok * DM + g * 8;
        float ssq_; { const f32x4 t4 = *(const f32x4*)(SSQ + (size_t)tok * 16 + 4 * g); ssq_ = (t4.x + t4.y) + (t4.z + t4.w); ssq_ = swap16_sum(ssq_, ssq_); ssq_ = swap32_sum(ssq_, ssq_); }
        const float rsl = rsqrtf(ssq_ * (1.0f / DM) + EPS) * LOG2E;
        u32x4 kp0, kp1;
        { const bf16_t* ks = KEYS + (size_t)krow * 64 + kch * 8; kp0 = *(const u32x4*)ks; kp1 = *(const u32x4*)(ks + 8 * 64); }
        __syncthreads();
        *(LAS u32x4*)(F.lds + kw0) = kp0; *(LAS u32x4*)(F.lds + kw1) = kp1;
        __syncthreads();
#pragma unroll 1
        for (int h = 0; h < 8; ++h) {
            float sv0[16], sv1[16];
#pragma unroll
            for (int p = 0; p < 2; ++p) {
                const int hp = h * 2 + p;
                if (hp + 1 < 16) { const bf16_t* ks = KEYS + (size_t)((hp + 1) * 128 + krow) * 64 + kch * 8; kp0 = *(const u32x4*)ks; kp1 = *(const u32x4*)(ks + 8 * 64); }
                const bf16x8 bq0 = *(const bf16x8*)(qrow + h * 128 + p * 64), bq1 = *(const bf16x8*)(qrow + h * 128 + p * 64 + 32);
                LAS const unsigned char* kb = F.lds + p * 16384 + kra;
                float va[16], vb[16];
#pragma unroll
                for (int kt = 0; kt < 8; ++kt) {
                    const bf16x8 a0 = *(LAS const bf16x8*)(kb + kt * 2048 + (((unsigned)g ^ ksw) << 4)), a1 = *(LAS const bf16x8*)(kb + kt * 2048 + (((unsigned)(4 + g) ^ ksw) << 4));
                    f32x4 acc = {0.f, 0.f, 0.f, 0.f};
                    acc = __builtin_amdgcn_mfma_f32_16x16x32_bf16(a0, bq0, acc, 0, 0, 0);
                    acc = __builtin_amdgcn_mfma_f32_16x16x32_bf16(a1, bq1, acc, 0, 0, 0);
#pragma unroll
                    for (int r = 0; r < 4; ++r) { const float x = __uint_as_float((__float_as_uint(acc[r]) & 0xFFFFFF80u) | (unsigned)(kt * 16 + r) | (unsigned)(4 * g));
                        if (kt < 4) va[kt * 4 + r] = x; else vb[(kt - 4) * 4 + r] = x; }
                }
                if (hp + 1 < 16) { *(LAS u32x4*)(F.lds + (1 - p) * 16384 + kw0) = kp0; *(LAS u32x4*)(F.lds + (1 - p) * 16384 + kw1) = kp1; }
                __syncthreads();
                bitonic_sort_desc<16>(va); bitonic_sort_desc<16>(vb);
#pragma unroll
                for (int i = 0; i < 16; ++i) va[i] = vmaxr(va[i], vb[15 - i]);
                bitonic_merge16_desc(va);
                merge_partner16<true>(va); merge_partner16<false>(va);
#pragma unroll
                for (int i = 0; i < 16; ++i) { if (p == 0) sv0[i] = va[i]; else sv1[i] = va[i]; }
            }
            float t[4];
#pragma unroll
            for (int j = 0; j < 4; ++j) t[j] = (g == 0) ? sv1[4 * j] : (g == 1) ? sv1[4 * j + 1] : (g == 2) ? sv1[4 * j + 2] : sv1[4 * j + 3];
#define CANDV(a, j) __uint_as_float((__float_as_uint(sv0[a] + t[j]) & 0xFFFFC000u) | ((__float_as_uint(sv0[a]) & 0x7Fu) << 7) | (__float_as_uint(t[j]) & 0x7Fu))
            float w[16];
#pragma unroll
            for (int a = 0; a < 16; ++a) w[a] = CANDV(a, 0);
            {
                float x0 = CANDV(0, 1), x1 = CANDV(1, 1), x2 = CANDV(2, 1), x3 = CANDV(0, 2), x4 = CANDV(0, 3);
                CEX_D(x0, x1); CEX_D(x3, x4); CEX_D(x2, x4); CEX_D(x2, x3); CEX_D(x0, x3); CEX_D(x0, x2); CEX_D(x1, x4); CEX_D(x1, x3); CEX_D(x1, x2);
                w[15] = vmaxr(w[15], x0); w[14] = vmaxr(w[14], x1); w[13] = vmaxr(w[13], x2); w[12] = vmaxr(w[12], x3); w[11] = vmaxr(w[11], x4);
                bitonic_merge16_desc(w);
            }
#undef CANDV
            merge_partner16<true>(w); merge_partner16<false>(w);
            float e[16]; float den = 0.f;
#pragma unroll
            for (int k = 0; k < 16; ++k) { e[k] = __builtin_amdgcn_exp2f((w[k] - w[0]) * rsl); den += e[k]; }
            const float inv = 1.0f / den;
            if (g == 0) {
                unsigned iw[8];
#pragma unroll
                for (int k = 0; k < 8; ++k) iw[k] = (__float_as_uint(w[2 * k]) & 0x3FFFu) | ((__float_as_uint(w[2 * k + 1]) & 0x3FFFu) << 16);
                u32x4* ip = (u32x4*)(IDX + (size_t)tok * 128 + h * 16);
                ip[0] = (u32x4){iw[0], iw[1], iw[2], iw[3]}; ip[1] = (u32x4){iw[4], iw[5], iw[6], iw[7]};
                f32x4* gp = (f32x4*)(GATE + (size_t)tok * 128 + h * 16);
#pragma unroll
                for (int k = 0; k < 4; ++k) gp[k] = (f32x4){e[4 * k] * inv, e[4 * k + 1] * inv, e[4 * k + 2] * inv, e[4 * k + 3] * inv};
            }
        }
    }
}

template <int PART>
__device__ __forceinline__ void phase_gather(const Ctx& F, int layer) {
    const unsigned char* Ut = F.ws + WS_U + (size_t)layer * NEXP * ROWB;
    const unsigned char* Vt = F.ws + WS_V + (size_t)layer * NEXP * ROWB;
    const float* SU = (const float*)(F.ws + WS_SU) + (size_t)layer * NEXP; const float* SV = (const float*)(F.ws + WS_SV) + (size_t)layer * NEXP;
    const unsigned short* IDX = (const unsigned short*)(F.ws + WS_IDX); const float* GATE = (const float*)(F.ws + WS_GATE);
    const float* gn = F.in[7] + (size_t)layer * DM;
    float* ACT = (float*)(F.ws + WS_ACTG);
    const float* gnext = F.in[1] + (size_t)(layer + 1 < DEPTH ? layer + 1 : 0) * DM;
    const int lane = F.lane, k = lane & 31, hf = lane >> 5;
    const int b3 = lane & 8, b2 = lane & 4, b1 = lane & 2;
    for (int tok = F.gw; tok < MTOK; tok += F.NGW) {
        bf16_t* xr = (bf16_t*)(F.ws + WS_X1B) + (size_t)tok * DM + 4 * k;
        f32x32 xh;
        {   float ss = 0.f;
#pragma unroll
            for (int i = 0; i < 8; ++i) { const u32x2 t2 = *(const u32x2*)(xr + 128 * i); const f32x4 t = {bf_lo(t2.x), bf_hi(t2.x), bf_lo(t2.y), bf_hi(t2.y)}; xh[4 * i] = t.x; xh[4 * i + 1] = t.y; xh[4 * i + 2] = t.z; xh[4 * i + 3] = t.w; ss += (t.x * t.x + t.y * t.y) + (t.z * t.z + t.w * t.w); }
            ss += dppf<DPP_XOR1>(ss); ss += dppf<DPP_XOR2>(ss); ss += dppf<DPP_HMIR>(ss); ss += dppf<DPP_RMIR>(ss); ss = swap16_sum(ss, ss);
            const float rs = rsqrtf(ss * (1.0f / DM) + EPS);
#pragma unroll
            for (int i = 0; i < 8; ++i) { const f32x4 g = *(const f32x4*)(gn + 4 * k + 128 * i); xh[4 * i] *= rs * g.x; xh[4 * i + 1] *= rs * g.y; xh[4 * i + 2] *= rs * g.z; xh[4 * i + 3] *= rs * g.w; } }
        const unsigned idxreg = ((const unsigned*)(IDX + (size_t)tok * 128))[lane];
        const int s0 = 2 * (16 * (k & 1) + (k >> 1)) + hf, s1 = 64 + s0;
        const unsigned e0 = IDX[(size_t)tok * 128 + s0], e1 = IDX[(size_t)tok * 128 + s1];
        const float gate0 = GATE[(size_t)tok * 128 + s0] * SV[e0], gate1 = GATE[(size_t)tok * 128 + s1] * SV[e1];
        const float su0 = SU[e0], su1 = SU[e1];
        float z0 = 0.f, z1 = 0.f;
#define G_LOAD(W_, T_, qb) do { _Pragma("unroll") for (int j = 0; j < 8; ++j) { \
            const unsigned wv = (unsigned)__builtin_amdgcn_readlane((int)idxreg, (qb) + j); const unsigned e = hf ? (wv >> 16) : (wv & 0xffffu); \
            W_[j] = *(const u32x6_a8*)(T_ + (size_t)e * ROWB + 24 * k); } } while (0)
#define G_UDOT(W_, P_, po) do { _Pragma("unroll") for (int j = 0; j < 8; ++j) { \
            const f32x32 d = __builtin_amdgcn_cvt_scalef32_pk32_f32_fp6(W_[j], 1.0f); f32x2_t ac[4]; \
            _Pragma("unroll") for (int c = 0; c < 4; ++c) ac[c] = (f32x2_t){d[2 * c], d[2 * c + 1]} * (f32x2_t){xh[2 * c], xh[2 * c + 1]}; \
            _Pragma("unroll") for (int i = 8; i < 32; i += 2) ac[(i >> 1) & 3] = (f32x2_t){d[i], d[i + 1]} * (f32x2_t){xh[i], xh[i + 1]} + ac[(i >> 1) & 3]; \
            const f32x2_t as_ = (ac[0] + ac[1]) + (ac[2] + ac[3]); P_[(po) + j] = as_.x + as_.y; } } while (0)
#define G_VACC(W_, qb) do { const float asel = ((qb) < 32) ? act0 : act1; _Pragma("unroll") for (int j = 0; j < 8; ++j) { \
            const int al_ = 2 * (((qb) + j) & 15) + ((((qb) + j) >> 4) & 1); \
            const float alo = __uint_as_float((unsigned)__builtin_amdgcn_readlane((int)__float_as_uint(asel), al_)); \
            const float ahi = __uint_as_float((unsigned)__builtin_amdgcn_readlane((int)__float_as_uint(asel), 32 + al_)); \
            const float a = hf ? ahi : alo; const f32x32 d = __builtin_amdgcn_cvt_scalef32_pk32_f32_fp6(W_[j], 1.0f); o = d * a + o; } } while (0)
        u32x6 wA[8], wB[8];
        if (PART == 0) {
            G_LOAD(wA, Ut, 0);
#pragma unroll 1
            for (int q0 = 0; q0 < 64; q0 += 16) {
                float p[16];
                G_LOAD(wB, Ut, q0 + 8);
                G_UDOT(wA, p, 0);
                if (q0 + 16 < 64) G_LOAD(wA, Ut, q0 + 16);
                G_UDOT(wB, p, 8);
                float q8[8], q4[4], q2[2];
#pragma unroll
                for (int j = 0; j < 8; ++j) q8[j] = swap16_sum(p[j], p[j + 8]);
#pragma unroll
                for (int j = 0; j < 4; ++j) { const float send = b3 ? q8[j] : q8[j + 4], keep = b3 ? q8[j + 4] : q8[j]; q4[j] = keep + dppf<DPP_RMIR>(send); }
#pragma unroll
                for (int j = 0; j < 2; ++j) { const float send = b2 ? q4[j] : q4[j + 2], keep = b2 ? q4[j + 2] : q4[j]; q2[j] = keep + dppf<DPP_HMIR>(send); }
                float pz;
                { const float send = b1 ? q2[0] : q2[1], keep = b1 ? q2[1] : q2[0]; pz = keep + dppf<DPP_XOR2>(send); }
                pz += dppf<DPP_XOR1>(pz);
                if ((k & 1) == ((q0 >> 4) & 1)) { if (q0 < 32) z0 = pz; else z1 = pz; }
            }
        }
        z0 *= su0; z1 *= su1;
        float act0, act1;
        if (PART == 0) { act0 = 0.5f * z0 * (1.0f + erff(z0 * 0.70710678118654752f)) * gate0; act1 = 0.5f * z1 * (1.0f + erff(z1 * 0.70710678118654752f)) * gate1; }
        else { act0 = ACT[(size_t)tok * 128 + s0]; act1 = ACT[(size_t)tok * 128 + s1]; }
        if (PART == 0) { ACT[(size_t)tok * 128 + s0] = act0; ACT[(size_t)tok * 128 + s1] = act1; continue; }
        f32x32 o;
#pragma unroll
        for (int i = 0; i < 32; ++i) o[i] = 0.f;
        G_LOAD(wA, Vt, 0);
#pragma unroll 1
        for (int q0 = 0; q0 < 64; q0 += 16) {
            G_LOAD(wB, Vt, q0 + 8);
            G_VACC(wA, q0);
            if (q0 + 16 < 64) G_LOAD(wA, Vt, q0 + 16);
            G_VACC(wB, q0 + 8);
        }
#undef G_LOAD
#undef G_UDOT
#undef G_VACC
        float xn[16]; float s2 = 0.f;
#pragma unroll
        for (int i = 0; i < 16; ++i) {
            const float tot = swap32_sum(o[i], o[i + 16]);
            xn[i] = tot;
        }
        bf16_t* xw = xr + 512 * hf;
#pragma unroll
        for (int i = 0; i < 4; ++i) { const u32x2 t2 = *(const u32x2*)(xw + 128 * i); xn[4 * i] += bf_lo(t2.x); xn[4 * i + 1] += bf_hi(t2.x); xn[4 * i + 2] += bf_lo(t2.y); xn[4 * i + 3] += bf_hi(t2.y); }
        if (layer + 1 < DEPTH) {
#pragma unroll
            for (int i = 0; i < 4; ++i) { u32x2 w; w.x = cvtpk(xn[4 * i], xn[4 * i + 1]); w.y = cvtpk(xn[4 * i + 2], xn[4 * i + 3]); *(u32x2*)(xw + 128 * i) = w; }
        } else {
            float* ow = F.out + (size_t)tok * DM + 4 * k + 512 * hf;
#pragma unroll
            for (int i = 0; i < 4; ++i) *(f32x4*)(ow + 128 * i) = (f32x4){xn[4 * i], xn[4 * i + 1], xn[4 * i + 2], xn[4 * i + 3]};
        }
        if (layer + 1 < DEPTH) {
#pragma unroll
            for (int i = 0; i < 16; ++i) s2 += xn[i] * xn[i];
            const float rs2 = rsqrtf(wave_sum(s2) * (1.0f / DM) + EPS);
            const float* gp = gnext + 4 * k + 512 * hf;
            bf16_t* hr = (bf16_t*)(F.ws + WS_H) + (size_t)tok * DM + 4 * k + 512 * hf;
#pragma unroll
            for (int i = 0; i < 4; ++i) { const f32x4 g = *(const f32x4*)(gp + 128 * i);
                u32x2 w; w.x = cvtpk(xn[4 * i] * rs2 * g.x, xn[4 * i + 1] * rs2 * g.y); w.y = cvtpk(xn[4 * i + 2] * rs2 * g.z, xn[4 * i + 3] * rs2 * g.w);
                *(u32x2*)(hr + 128 * i) = w; }
        }
    }
}

#define GAS __attribute__((address_space(1)))
#define XB_TMO      128
#define XB_XCNT(j)  (256  + 64 * (j))
#define XB_XSUB(j)  (1280 + 64 * (j))
#define XB_XGEN(j)  (2304 + 64 * (j))
#define XB_TOP      3328
#define XB_TOPGEN   3392
#define XCD_BAR_WORDS 3456
#define XB_SPIN_CAP (1u << 18)

__device__ __forceinline__ unsigned xb_ld(unsigned* p)              { return __hip_atomic_load(p, __ATOMIC_RELAXED, __HIP_MEMORY_SCOPE_AGENT); }
__device__ __forceinline__ unsigned xb_add(unsigned* p, unsigned v) { return __hip_atomic_fetch_add(p, v, __ATOMIC_RELAXED, __HIP_MEMORY_SCOPE_AGENT); }
__device__ __forceinline__ unsigned xb_xcc_id() { return (unsigned)__builtin_amdgcn_s_getreg((3 << 11) | 20) & 0xFu; }
#define XB_SPIN(cond, bar) do { unsigned _sp = 0; while (cond) { __builtin_amdgcn_s_sleep(1); \
    if ((++_sp & 255u) == 0u) { if (xb_ld(&(bar)[XB_TMO])) break; if (_sp > XB_SPIN_CAP) { atomicAdd(&(bar)[XB_TMO], 1u); break; } } } } while (0)

struct XcdBarrier {
    unsigned* bar; unsigned x;
    volatile LAS unsigned* st;
};

__device__ __forceinline__ XcdBarrier xcd_barrier_post(unsigned* bar, volatile LAS unsigned* st) {
    XcdBarrier b; b.bar = bar; b.x = xb_xcc_id(); b.st = st;
    if (threadIdx.x == 0) (void)xb_add(&bar[XB_XCNT(b.x)], 1u);
    return b;
}
__device__ __forceinline__ void xcd_barrier_complete(unsigned* bar, unsigned x, unsigned& nloc, unsigned& nx) {
    const unsigned G = gridDim.x * gridDim.y * gridDim.z;
    unsigned sum, cnt, mine, sp = 0u;
    for (;;) {
        sum = 0u; cnt = 0u; mine = 0u;
#pragma unroll
        for (unsigned j = 0; j < 16; ++j) { const unsigned c = xb_ld(&bar[XB_XCNT(j)]); sum += c; cnt += (c > 0u) ? 1u : 0u; mine = (j == x) ? c : mine; }
        if (sum == G) break;
        __builtin_amdgcn_s_sleep(1);
        if ((++sp & 255u) == 0u) { if (xb_ld(&bar[XB_TMO])) break; if (sp > XB_SPIN_CAP) { atomicAdd(&bar[XB_TMO], 1u); break; } }
    }
    nloc = mine > 0u ? mine : 1u; nx = cnt > 0u ? cnt : 1u;
}

__device__ __forceinline__ void xcd_barrier(const XcdBarrier& b) {
    asm volatile("s_waitcnt vmcnt(0)" ::: "memory");
    __syncthreads();
    if (threadIdx.x == 0) {
        unsigned* bar = b.bar;
        __builtin_amdgcn_s_waitcnt(0);
        unsigned nloc = b.st[0], nx = b.st[1];
        if (nloc == 0u) { xcd_barrier_complete(bar, b.x, nloc, nx); b.st[0] = nloc; b.st[1] = nx; }
        const unsigned old = xb_add(&bar[XB_XSUB(b.x)], 1u);
        const unsigned gen = old / nloc;
        if (old + 1u == (gen + 1u) * nloc) {
            __builtin_amdgcn_fence(__ATOMIC_RELEASE, "agent");
            asm volatile("s_waitcnt vmcnt(0)" ::: "memory");
            const unsigned og = xb_add(&bar[XB_TOP], 1u);
            const unsigned tg = og / nx;
            if (og + 1u == (tg + 1u) * nx) xb_add(&bar[XB_TOPGEN], 1u);
            else XB_SPIN(xb_ld(&bar[XB_TOPGEN]) == tg, bar);
            __builtin_amdgcn_fence(__ATOMIC_ACQUIRE, "agent");
            xb_add(&bar[XB_XGEN(b.x)], 1u);
            asm volatile("s_waitcnt vmcnt(0)" ::: "memory");
        } else {
            XB_SPIN(xb_ld(&bar[XB_XGEN(b.x)]) == gen, bar);
            __builtin_amdgcn_fence(__ATOMIC_ACQUIRE, "agent");
            asm volatile("s_waitcnt vmcnt(0)" ::: "memory");
        }
    }
    __syncthreads();
}

constexpr int PH_PER_LAYER = 9;
constexpr int N_PHASES = 1 + PH_PER_LAYER * DEPTH;
struct Args { const float* in[12]; float* out; unsigned char* ws; int ph_lo, ph_hi; };
__global__ void __launch_bounds__(NTHREADS, 2) mk_fwd(Args args) {
    extern __shared__ __attribute__((aligned(16))) unsigned char lds_raw[];
#define MKCTX() Ctx F; { int t_ = threadIdx.x, b_ = blockIdx.x; asm volatile("" : "+v"(t_)); asm volatile("" : "+s"(b_)); \
        F.lds = (LAS unsigned char*)lds_raw; F.tid = t_; F.lane = t_ & 63; F.wave = __builtin_amdgcn_readfirstlane(t_ >> 6); F.G = gridDim.x; \
        F.vcu = (F.G % 8 == 0) ? (b_ % 8) * (F.G / 8) + b_ / 8 : b_; F.gw = F.vcu * NWAVES + F.wave; F.NGW = F.G * NWAVES; F.in = args.in; F.out = args.out; F.ws = args.ws; }
    const int lo = args.ph_lo, hi = args.ph_hi;
    volatile LAS unsigned* MISC = (volatile LAS unsigned*)((LAS unsigned char*)lds_raw + 131072);
    if (threadIdx.x < 16) MISC[threadIdx.x] = 0u;
    __syncthreads();
    XcdBarrier bar = xcd_barrier_post((unsigned*)(args.ws + WS_CTL) + 4096, MISC + 8);
#define IN(k) (lo <= (k) && (k) < hi)
#define SEAM(k) do { if (IN(k) && IN((k) + 1)) { if ((k) == 0) cg::this_grid().sync(); else xcd_barrier(bar); } } while (0)
#ifndef DUP_PH
#define DUP_PH -1
#endif
#define PH(k, kk, ...) do { if (IN(k)) { __VA_ARGS__; if (DUP_PH == (kk)) { xcd_barrier(bar); __VA_ARGS__; } } SEAM(k); } while (0)
    PH(0, 0, { MKCTX(); phase_p0(F); });
#pragma unroll 1
    for (int l = 0; l < DEPTH; ++l) {
        const int pb = 1 + PH_PER_LAYER * l;
        bf16_t* H = (bf16_t*)(args.ws + WS_H);
        PH(pb + 0, 1, {
            pg8::Gemm g{H, (const bf16_t*)(args.ws + WS_WIN) + (size_t)l * PW * DM, MTOK, PW, DM}; pg8::StaticOrder S; S.init(MTOK, PW, (int)gridDim.x, (int)blockIdx.x);
            pg8::EpiBf16 E{(bf16_t*)(args.ws + WS_P), PW};
            pg8::gemm_phase<pg8::EpiBf16, pg8::StaticOrder, true, true>((LAS unsigned char*)lds_raw, g, S, E); });
        PH(pb + 1, -2, { MKCTX(); phase_rope(F, F.in[3] + l * 384); });
        PH(pb + 2, 3, { MKCTX(); phase_attn(F, F.in[4] + l * 4, F.in[3] + l * 384); });
        PH(pb + 3, 4, { MKCTX(); phase_post(F, F.in[5] + l * DM); });
        PH(pb + 4, -2, {
            pg8::Gemm g{H, (const bf16_t*)(args.ws + WS_WOUT) + (size_t)l * DM * DM, MTOK, DM, DM}; pg8::StaticOrder S; S.init(MTOK, DM, (int)gridDim.x, (int)blockIdx.x);
            bf16_t* XB = (bf16_t*)(args.ws + WS_X1B); float* SQ = (float*)(args.ws + WS_SSQ) + (size_t)l * MTOK * 16;
            if (l == 0) { pg8::EpiResBf16<true> E{(const void*)args.in[0], XB, SQ, DM}; pg8::gemm_phase<pg8::EpiResBf16<true>, pg8::StaticOrder, true, true>((LAS unsigned char*)lds_raw, g, S, E); }
            else { pg8::EpiResBf16<false> E{(const void*)XB, XB, SQ, DM}; pg8::gemm_phase<pg8::EpiResBf16<false>, pg8::StaticOrder, true, true>((LAS unsigned char*)lds_raw, g, S, E); } });
        PH(pb + 5, 7, {
            pg8::Gemm g{(const bf16_t*)(args.ws + WS_X1B), (const bf16_t*)(args.ws + WS_WQ) + (size_t)l * DM * DM, MTOK, DM, DM}; pg8::StaticOrder S; S.init(MTOK, DM, (int)gridDim.x, (int)blockIdx.x);
            pg8::EpiBf16 E{(bf16_t*)(args.ws + WS_Q), DM};
            pg8::gemm_phase<pg8::EpiBf16, pg8::StaticOrder, true, true>((LAS unsigned char*)lds_raw, g, S, E); });
        PH(pb + 6, 8, { MKCTX(); phase_route(F, l); });
        PH(pb + 7, -2, { MKCTX(); phase_gather<0>(F, l); });
        PH(pb + 8, -2, { MKCTX(); phase_gather<1>(F, l); });
    }
#undef IN
#undef SEAM
}

#ifndef MK_ONE_LAUNCH
#define MK_ONE_LAUNCH 1
#endif
extern "C" void kernel_launch(void* const* d_in, const int* in_sizes, int n_in, void* d_out, int out_size, void* d_ws, size_t ws_size, hipStream_t stream) {
    static int grid = 0;
    if (grid == 0) {
        if (n_in != 12 || ws_size < WS_END) { fprintf(stderr, "kernel_launch: unexpected n_in %d / ws %zu\n", n_in, ws_size); grid = -1; return; }
        int dev = 0, cus = 0, per_cu = 0;
        if (hipGetDevice(&dev) != hipSuccess || hipDeviceGetAttribute(&cus, hipDeviceAttributeMultiprocessorCount, dev) != hipSuccess) { grid = -1; return; }
        if (hipFuncSetAttribute((const void*)mk_fwd, hipFuncAttributeMaxDynamicSharedMemorySize, LDS_BYTES) != hipSuccess) { fprintf(stderr, "kernel_launch: hipFuncSetAttribute failed\n"); grid = -1; return; }
        if (hipOccupancyMaxActiveBlocksPerMultiprocessor(&per_cu, (const void*)mk_fwd, NTHREADS, LDS_BYTES) != hipSuccess || per_cu < 1) { fprintf(stderr, "kernel_launch: occupancy query failed (%d)\n", per_cu); (void)hipGetLastError(); grid = -1; return; }
        grid = cus * per_cu;
        fprintf(stderr, "kernel_launch: cus %d per_cu %d grid %d\n", cus, per_cu, grid);
    }
    if (grid < 0) return;
    if (hipMemsetAsync((char*)d_ws + WS_CTL, 0, CTL_BYTES, stream) != hipSuccess) { fprintf(stderr, "kernel_launch: memset failed\n"); return; }
    Args a{};
    for (int i = 0; i < 12; ++i) a.in[i] = (const float*)d_in[i];
    a.out = (float*)d_out; a.ws = (unsigned char*)d_ws;
#if MK_ONE_LAUNCH
    a.ph_lo = 0; a.ph_hi = N_PHASES;
    void* kargs[] = {&a};
    hipError_t e = hipLaunchCooperativeKernel((const void*)mk_fwd, dim3(grid), dim3(NTHREADS), kargs, LDS_BYTES, stream);
    if (e != hipSuccess) fprintf(stderr, "cooperative launch failed: %s (grid %d)\n", hipGetErrorString(e), grid);
#else
    for (int p = 0; p < N_PHASES; ++p) { a.ph_lo = p; a.ph_hi = p + 1; hipLaunchKernelGGL(mk_fwd, dim3(grid), dim3(NTHREADS), LDS_BYTES, stream, a); }
#endif
}
```

```cpp
#include <hip/hip_runtime.h>
#include <hip/hip_cooperative_groups.h>
#include <cstdio>
#include <cstdint>
#include <cmath>
namespace cg = cooperative_groups;

constexpr int BATCH = 16, SEQ = 2048, DM = 1024, DEPTH = 2;
constexpr int MTOK = BATCH * SEQ;
constexpr int PW = 2304;
constexpr int NKEYS = 128, NEXP = NKEYS * NKEYS;
constexpr float EPS = 1e-6f;
constexpr int C_QA = 0, C_KA = 384, C_VA = 512, C_QB = 640, C_KB = 1024, C_VB = 1408, C_QC = 1792, C_KC = 2048, C_VC = 2176;
constexpr float LOG2E = 1.4426950408889634f;
constexpr float QSCALE = 0.125f * LOG2E;

#define LAS __attribute__((address_space(3)))
typedef unsigned short bf16_t;
typedef short bf16x8 __attribute__((ext_vector_type(8)));
typedef short s16x4 __attribute__((ext_vector_type(4)));
typedef float f32x4 __attribute__((ext_vector_type(4)));
typedef float f32x16 __attribute__((ext_vector_type(16)));
typedef unsigned u32x4 __attribute__((ext_vector_type(4)));
typedef unsigned u32x2 __attribute__((ext_vector_type(2)));
typedef float f32x2_t __attribute__((ext_vector_type(2)));
typedef float f32x32 __attribute__((ext_vector_type(32)));
typedef unsigned u32x6 __attribute__((ext_vector_type(6)));
typedef u32x6 u32x6_a8 __attribute__((aligned(8)));
typedef __bf16 bf16x2_t __attribute__((ext_vector_type(2)));

__device__ __forceinline__ unsigned cvtpk(float lo, float hi) { f32x2_t v = {lo, hi}; bf16x2_t b = __builtin_convertvector(v, bf16x2_t); return __builtin_bit_cast(unsigned, b); }
__device__ __forceinline__ float bf_lo(unsigned w) { return __uint_as_float(w << 16); }
__device__ __forceinline__ float bf_hi(unsigned w) { return __uint_as_float(w & 0xffff0000u); }
template <int CTRL> __device__ __forceinline__ float dppf(float x) { return __uint_as_float((unsigned)__builtin_amdgcn_update_dpp(0, (int)__float_as_uint(x), CTRL, 0xF, 0xF, true)); }
#define DPP_XOR1 0xB1
#define DPP_XOR2 0x4E
#define DPP_XOR3 0x1B
#define DPP_HMIR 0x141
#define DPP_RMIR 0x140
__device__ __forceinline__ float swap16_sum(float a, float b) { auto r = __builtin_amdgcn_permlane16_swap(__float_as_uint(a), __float_as_uint(b), false, false); return __uint_as_float(r[0]) + __uint_as_float(r[1]); }
__device__ __forceinline__ float swap32_sum(float a, float b) { auto r = __builtin_amdgcn_permlane32_swap(__float_as_uint(a), __float_as_uint(b), false, false); return __uint_as_float(r[0]) + __uint_as_float(r[1]); }
__device__ __forceinline__ float swap16_max(float a) { auto r = __builtin_amdgcn_permlane16_swap(__float_as_uint(a), __float_as_uint(a), false, false); return fmaxf(__uint_as_float(r[0]), __uint_as_float(r[1])); }
__device__ __forceinline__ float swap32_max(float a) { auto r = __builtin_amdgcn_permlane32_swap(__float_as_uint(a), __float_as_uint(a), false, false); return fmaxf(__uint_as_float(r[0]), __uint_as_float(r[1])); }
__device__ __forceinline__ float wave_sum(float v) {
    v += dppf<DPP_XOR1>(v); v += dppf<DPP_XOR2>(v); v += dppf<DPP_HMIR>(v); v += dppf<DPP_RMIR>(v);
    v = swap16_sum(v, v); v = swap32_sum(v, v);
    return v;
}
__device__ __forceinline__ float wave_max(float v) {
    v = fmaxf(v, dppf<DPP_XOR1>(v)); v = fmaxf(v, dppf<DPP_XOR2>(v)); v = fmaxf(v, dppf<DPP_HMIR>(v)); v = fmaxf(v, dppf<DPP_RMIR>(v));
    v = swap16_max(v); v = swap32_max(v);
    return v;
}

constexpr size_t MiB = 1u << 20;
constexpr size_t WS_CTL = 0, CTL_BYTES = 1 * MiB;
constexpr size_t WS_WIN = 1 * MiB;
constexpr size_t WS_WOUT = 10 * MiB;
constexpr size_t WS_WQ = 14 * MiB;
constexpr size_t WS_KEYS = 18 * MiB;
constexpr size_t WS_LSE = 19 * MiB;
constexpr size_t WS_ROPE = 22 * MiB;
constexpr size_t WS_U = 24 * MiB;
constexpr size_t WS_V = 48 * MiB;
constexpr int ROWB = 768;
constexpr size_t WS_SU = 72 * MiB;
constexpr size_t WS_SV = 73 * MiB;
constexpr size_t WS_H = 152 * MiB;
constexpr size_t WS_P = 216 * MiB;
constexpr size_t WS_MIX = 360 * MiB;
constexpr size_t WS_OB = 424 * MiB;
constexpr size_t WS_END = 496 * MiB;
constexpr size_t WS_X1B = 88 * MiB;
constexpr size_t WS_SSQ = 74 * MiB;
constexpr size_t WS_ACTG = WS_P + 96 * MiB;
constexpr size_t WS_Q = WS_P;
constexpr size_t WS_IDX = WS_P + 64 * MiB;
constexpr size_t WS_GATE = WS_P + 72 * MiB;

constexpr int NWAVES = 8, NTHREADS = 512;
constexpr int LDS_BYTES = 147456;

namespace pg8 {
using ::u32x2;
#define PG8_LAS __attribute__((address_space(3)))
typedef unsigned short bf16_t;
typedef short bf16x8 __attribute__((ext_vector_type(8)));
typedef float f32x4 __attribute__((ext_vector_type(4)));
typedef unsigned u32x4 __attribute__((ext_vector_type(4)));
constexpr int BM = 256, BK = 64, HALF = 128, HTB = HALF * BK * 2  , STAGE_BYTES = 8 * HTB, NXCD = 8, WGM = 8;

__host__ __device__ __forceinline__ int lds_byte(int r, int c) { const int st = (r >> 4) * 2 + (c >> 5), rr = r & 15, cc = c & 31, ob = rr * 64 + cc * 2; return st * 1024 + (ob ^ (((ob >> 9) & 1) << 5)); }
__host__ __device__ __forceinline__ void stage_rc(int b, int& R, int& C) { const int st = b / 1024, sb = b % 1024, swz = sb ^ (((sb >> 9) & 1) << 5); R = (st >> 1) * 16 + swz / 64; C = (st & 1) * 32 + (swz % 64) / 2; }
__host__ __device__ __forceinline__ int perm32(int rho) { const int n = rho >> 4, i = rho & 15; return 8 * (i >> 2) + 4 * n + (i & 3); }

struct Unit { int pm, pn; };
struct Gemm { const bf16_t* A; const bf16_t* Bt; int M, N, K; };

struct StaticOrder {
    int nM, nN, nwg, G, c;
    __host__ __device__ void init(int M, int N, int G_, int c_) { nM = M / BM; nN = N / BM; nwg = nM * nN; G = G_; c = c_; }
    __host__ __device__ bool next(int i, Unit& u) const {
        const long L = (long)i * G + c; if (L >= nwg) return false;
        int wgid = (int)L; { const int q = nwg / NXCD, r = nwg % NXCD, xcd = wgid % NXCD, off = wgid / NXCD; wgid = (xcd < r ? xcd * (q + 1) : r * (q + 1) + (xcd - r) * q) + off; }
        const int nig = WGM * nN, gid = wgid / nig, fm = gid * WGM, gsz = (nM - fm) < WGM ? (nM - fm) : WGM;
        u.pm = fm + ((wgid % nig) % gsz); u.pn = (wgid % nig) / gsz; return true;
    }
    __device__ __forceinline__ void a_ready(const Unit&) const {}
    __device__ __forceinline__ void done(const Unit&) const {}
};


struct EpiBf16 {
    static constexpr bool PERM = true, AFTER_DRAIN = false;
    bf16_t* O; int ldc;
    __device__ __forceinline__ void operator()(const f32x4 (&acc)[2][2][4][2], const Unit& u, int wr, int wc, int fr, int fq) const {
        const int row0 = u.pm * BM + wr * 64 + fr; const int col0 = u.pn * BM + wc * 32 + 8 * fq;
#pragma unroll
        for (int ai = 0; ai < 2; ++ai)
#pragma unroll
            for (int m = 0; m < 4; ++m) { bf16_t* rowp = O + (size_t)(row0 + ai * HALF + m * 16) * ldc + col0;
#pragma unroll
                for (int bj = 0; bj < 2; ++bj) { const f32x4 v0 = acc[ai][bj][m][0], v1 = acc[ai][bj][m][1];
                    u32x4 w; w.x = ::cvtpk(v0[0], v0[1]); w.y = ::cvtpk(v0[2], v0[3]); w.z = ::cvtpk(v1[0], v1[1]); w.w = ::cvtpk(v1[2], v1[3]);
                    *(u32x4*)(rowp + bj * HALF) = w; } }
    }
};
template <bool BASE_F32>
struct EpiResBf16 {
    static constexpr bool PERM = true, AFTER_DRAIN = false;
    const void* base; bf16_t* Xb; float* ssq; int ldc;
    __device__ __forceinline__ void operator()(const f32x4 (&acc)[2][2][4][2], const Unit& u, int wr, int wc, int fr, int fq) const {
        const int row0 = u.pm * BM + wr * 64 + fr, col0 = u.pn * BM + wc * 32 + 8 * fq;
#pragma unroll
        for (int ai = 0; ai < 2; ++ai)
#pragma unroll
            for (int m = 0; m < 4; ++m) { const int row = row0 + ai * HALF + m * 16; const size_t off = (size_t)row * ldc + col0; float s = 0.f;
#pragma unroll
                for (int bj = 0; bj < 2; ++bj) { f32x4 v0 = acc[ai][bj][m][0], v1 = acc[ai][bj][m][1];
                    if (BASE_F32) { const float* bp = (const float*)base + off + bj * HALF; v0 = v0 + *(const f32x4*)bp; v1 = v1 + *(const f32x4*)(bp + 4); }
                    else { const u32x4 b = *(const u32x4*)((const bf16_t*)base + off + bj * HALF);
                        v0 = v0 + (f32x4){::bf_lo(b.x), ::bf_hi(b.x), ::bf_lo(b.y), ::bf_hi(b.y)}; v1 = v1 + (f32x4){::bf_lo(b.z), ::bf_hi(b.z), ::bf_lo(b.w), ::bf_hi(b.w)}; }
                    s += ((v0[0] * v0[0] + v0[1] * v0[1]) + (v0[2] * v0[2] + v0[3] * v0[3])) + ((v1[0] * v1[0] + v1[1] * v1[1]) + (v1[2] * v1[2] + v1[3] * v1[3]));
                    u32x4 w; w.x = ::cvtpk(v0[0], v0[1]); w.y = ::cvtpk(v0[2], v0[3]); w.z = ::cvtpk(v1[0], v1[1]); w.w = ::cvtpk(v1[2], v1[3]);
                    *(u32x4*)(Xb + off + bj * HALF) = w; }
                s = ::swap16_sum(s, s); s = ::swap32_sum(s, s);
                if (fq == 0) ssq[(size_t)row * 16 + u.pn * 4 + wc] = s; }
    }
};

template <class Epi, class Sched, bool ALIGN_EPI = false, bool SP2 = false>
__device__ __forceinline__ void gemm_phase(PG8_LAS unsigned char* lds, const Gemm g, const Sched& S, const Epi& E) {
    int tid_l = threadIdx.x; asm volatile("" : "+v"(tid_l));
    const int tid = tid_l, wid = __builtin_amdgcn_readfirstlane(tid >> 6), lane = tid & 63, wr = wid >> 2, wc = wid & 3, fr = lane & 15, fq = lane >> 4;
    const int K = g.K, nt = K / BK;
    unsigned voffA[2], voffB[2];
#pragma unroll
    for (int i = 0; i < 2; ++i) { int R, C; stage_rc(tid * 16 + i * 8192, R, C); const int Rb = Epi::PERM ? ((R & ~31) + perm32(R & 31)) : R;
        voffA[i] = (unsigned)(R * K + C) * 2u; voffB[i] = (unsigned)(Rb * K + C) * 2u; }
    const size_t kstep = (size_t)(BK * 2);
    const size_t hstep = (size_t)HALF * K * 2;
    const size_t tstep = 2 * hstep;
    const unsigned ldsw = (unsigned)wid * 1024u;
    const int aoff = lds_byte(wr * 64 + fr, fq * 8), boff = lds_byte(wc * 32 + fr, fq * 8);
#define PG8_SA(b, h) (((b) * 2 + (h)) * HTB)
#define PG8_SB(b, h) ((4 + (b) * 2 + (h)) * HTB)
#define PG8_STAGE(bufoff, gbase, voff) do { _Pragma("unroll") for (int _i = 0; _i < 2; ++_i) \
        __builtin_amdgcn_global_load_lds((const unsigned*)((const char*)(gbase) + (voff)[_i]), (PG8_LAS unsigned*)(lds + (bufoff) + ldsw + _i * 8192), 16, 0, 0); } while (0)
#define PG8_LDA(dst, b, h) do { _Pragma("unroll") for (int m = 0; m < 4; ++m) _Pragma("unroll") for (int k = 0; k < 2; ++k) dst[m][k] = *(const PG8_LAS bf16x8*)(lds + PG8_SA(b, h) + aoff + m * 2048 + k * 1024); } while (0)
#define PG8_LDB(dst, b, h) do { _Pragma("unroll") for (int n = 0; n < 2; ++n) _Pragma("unroll") for (int k = 0; k < 2; ++k) dst[n][k] = *(const PG8_LAS bf16x8*)(lds + PG8_SB(b, h) + boff + n * 2048 + k * 1024); } while (0)
#define PG8_MMA(ai, bj, At, Bt) do { __builtin_amdgcn_s_setprio(1); _Pragma("unroll") for (int m = 0; m < 4; ++m) _Pragma("unroll") for (int n = 0; n < 2; ++n) _Pragma("unroll") for (int k = 0; k < 2; ++k) \
        acc[ai][bj][m][n] = __builtin_amdgcn_mfma_f32_16x16x32_bf16(Bt[n][k], At[m][k], acc[ai][bj][m][n], 0, 0, 0); __builtin_amdgcn_s_setprio(0); } while (0)
#define PG8_WAIT_V(n) asm volatile("s_waitcnt vmcnt(" #n ")" ::: "memory")
#define PG8_WAIT_L(n) asm volatile("s_waitcnt lgkmcnt(" #n ")" ::: "memory")
#define PG8_BAR __builtin_amdgcn_s_barrier()
#define PG8_SCHED __builtin_amdgcn_sched_barrier(0)
    Unit cur, nxt; int ui = 0;
    if (!S.next(0, cur)) return;
    f32x4 acc[2][2][4][2];
#pragma unroll
    for (int a = 0; a < 2; ++a)
#pragma unroll
        for (int b = 0; b < 2; ++b)
#pragma unroll
            for (int m = 0; m < 4; ++m)
#pragma unroll
                for (int n = 0; n < 2; ++n) acc[a][b][m][n] = (f32x4){0.f, 0.f, 0.f, 0.f};
    bf16x8 At[4][2], B0[2][2], B1[2][2];
    const char* cA = (const char*)g.A + (size_t)cur.pm * tstep; const char* cB = (const char*)g.Bt + (size_t)cur.pn * tstep;
    S.a_ready(cur);
    if constexpr (SP2) {
        PG8_STAGE(PG8_SB(0, 0), cB, voffB); PG8_STAGE(PG8_SB(0, 1), cB + hstep, voffB); PG8_STAGE(PG8_SA(0, 0), cA, voffA); PG8_STAGE(PG8_SA(0, 1), cA + hstep, voffA);
        if (wr == 1) PG8_BAR;
        PG8_WAIT_V(2); PG8_BAR;
        PG8_STAGE(PG8_SB(1, 0), cB + kstep, voffB); PG8_STAGE(PG8_SA(1, 0), cA + kstep, voffA); PG8_STAGE(PG8_SB(1, 1), cB + hstep + kstep, voffB);
        PG8_WAIT_V(6); PG8_BAR;
    } else {
        PG8_STAGE(PG8_SB(0, 0), cB, voffB); PG8_STAGE(PG8_SA(0, 0), cA, voffA); PG8_STAGE(PG8_SB(0, 1), cB + hstep, voffB); PG8_STAGE(PG8_SA(0, 1), cA + hstep, voffA);
        if (wr == 1) PG8_BAR;
        PG8_WAIT_V(4); PG8_BAR;
        PG8_STAGE(PG8_SB(1, 0), cB + kstep, voffB); PG8_STAGE(PG8_SA(1, 0), cA + kstep, voffA); PG8_STAGE(PG8_SB(1, 1), cB + hstep + kstep, voffB);
        PG8_WAIT_V(6); PG8_BAR;
    }
    for (;;) {
        const bool has_next = S.next(ui + 1, nxt);
        const char* nA = has_next ? (const char*)g.A + (size_t)nxt.pm * tstep : cA; const char* nB = has_next ? (const char*)g.Bt + (size_t)nxt.pn * tstep : cB;
        for (int t = 0; t < nt; t += 2) {
            const bool last = (t == nt - 2);
            const char* a1 = cA + (size_t)(t + 1) * kstep;
            const char* a2 = last ? nA : cA + (size_t)(t + 2) * kstep; const char* b2 = last ? nB : cB + (size_t)(t + 2) * kstep;
            const char* a3 = a2 + kstep; const char* b3 = b2 + kstep;
            if (last && has_next) S.a_ready(nxt);
            if constexpr (SP2) {
            PG8_LDB(B0, 0, 0); PG8_LDB(B1, 0, 1); PG8_SCHED; PG8_LDA(At, 0, 0); PG8_STAGE(PG8_SA(1, 1), a1 + hstep, voffA);
            PG8_WAIT_V(8); PG8_WAIT_L(0); PG8_BAR; PG8_MMA(0, 0, At, B0); PG8_MMA(0, 1, At, B1); PG8_BAR; PG8_SCHED;
            PG8_LDA(At, 0, 1); PG8_STAGE(PG8_SB(0, 0), b2, voffB); PG8_STAGE(PG8_SB(0, 1), b2 + hstep, voffB); PG8_STAGE(PG8_SA(0, 0), a2, voffA);
            PG8_WAIT_V(8); PG8_WAIT_L(0); PG8_BAR; PG8_MMA(1, 0, At, B0); PG8_MMA(1, 1, At, B1); PG8_BAR; PG8_SCHED;
            PG8_LDB(B0, 1, 0); PG8_LDB(B1, 1, 1); PG8_SCHED; PG8_LDA(At, 1, 0); PG8_STAGE(PG8_SA(0, 1), a2 + hstep, voffA);
            PG8_WAIT_V(8); PG8_WAIT_L(0); PG8_BAR; PG8_MMA(0, 0, At, B0); PG8_MMA(0, 1, At, B1); PG8_BAR; PG8_SCHED;
            PG8_LDA(At, 1, 1); PG8_STAGE(PG8_SB(1, 0), b3, voffB); PG8_STAGE(PG8_SB(1, 1), b3 + hstep, voffB); PG8_STAGE(PG8_SA(1, 0), a3, voffA);
            PG8_WAIT_V(8); PG8_WAIT_L(0); PG8_BAR; PG8_MMA(1, 0, At, B0); PG8_MMA(1, 1, At, B1); PG8_BAR; PG8_SCHED;
            } else {
            PG8_LDB(B0, 0, 0); PG8_SCHED; PG8_LDA(At, 0, 0); PG8_STAGE(PG8_SA(1, 1), a1 + hstep, voffA);
            PG8_WAIT_L(8); PG8_BAR; PG8_WAIT_L(0); PG8_MMA(0, 0, At, B0); PG8_BAR; PG8_SCHED;
            PG8_LDB(B1, 0, 1); PG8_STAGE(PG8_SB(0, 0), b2, voffB);
            PG8_BAR; PG8_WAIT_L(0); PG8_MMA(0, 1, At, B1); PG8_BAR;
            PG8_LDA(At, 0, 1); PG8_STAGE(PG8_SA(0, 0), a2, voffA);
            PG8_BAR; PG8_WAIT_L(0); PG8_MMA(1, 0, At, B0); PG8_BAR; PG8_SCHED;
            PG8_STAGE(PG8_SB(0, 1), b2 + hstep, voffB);
            PG8_WAIT_V(6); PG8_BAR; PG8_MMA(1, 1, At, B1); PG8_BAR;
            PG8_LDB(B0, 1, 0); PG8_SCHED; PG8_LDA(At, 1, 0); PG8_STAGE(PG8_SA(0, 1), a2 + hstep, voffA);
            PG8_WAIT_L(8); PG8_BAR; PG8_WAIT_L(0); PG8_MMA(0, 0, At, B0); PG8_BAR; PG8_SCHED;
            PG8_LDB(B1, 1, 1); PG8_STAGE(PG8_SB(1, 0), b3, voffB);
            PG8_BAR; PG8_WAIT_L(0); PG8_MMA(0, 1, At, B1); PG8_BAR;
            PG8_LDA(At, 1, 1); PG8_STAGE(PG8_SA(1, 0), a3, voffA);
            PG8_BAR; PG8_WAIT_L(0); PG8_MMA(1, 0, At, B0); PG8_BAR; PG8_SCHED;
            PG8_STAGE(PG8_SB(1, 1), b3 + hstep, voffB);
            PG8_WAIT_V(6); PG8_BAR; PG8_MMA(1, 1, At, B1); PG8_BAR;
            }
        }
        if constexpr (ALIGN_EPI) { if (wr == 0) PG8_BAR; }
        if constexpr (!Epi::AFTER_DRAIN) { E(acc, cur, wr, wc, fr, fq); S.done(cur); }
        if (!has_next) break;
#pragma unroll
        for (int a = 0; a < 2; ++a)
#pragma unroll
            for (int b = 0; b < 2; ++b)
#pragma unroll
                for (int m = 0; m < 4; ++m)
#pragma unroll
                    for (int n = 0; n < 2; ++n) acc[a][b][m][n] = (f32x4){0.f, 0.f, 0.f, 0.f};
        cur = nxt; cA = nA; cB = nB; ++ui;
        if constexpr (ALIGN_EPI) { if (wr == 1) PG8_BAR; }
    }
    PG8_WAIT_V(0);
    if constexpr (!ALIGN_EPI) { if (wr == 0) PG8_BAR; }
    PG8_BAR;
    if constexpr (Epi::AFTER_DRAIN) { E.fused(acc, cur, wr, wc, fr, fq, lds, wid, lane); S.done(cur); }
#undef PG8_SA
#undef PG8_SB
#undef PG8_STAGE
#undef PG8_LDA
#undef PG8_LDB
#undef PG8_MMA
#undef PG8_WAIT_V
#undef PG8_WAIT_L
#undef PG8_BAR
#undef PG8_SCHED
}
}

__device__ __forceinline__ int crow(int r, int hi) { return (r & 3) + 8 * (r >> 2) + 4 * hi; }
__device__ __forceinline__ float fmax3(float a, float b, float c) { return fmaxf(fmaxf(a, b), c); }

__device__ __forceinline__ void norm_row_to_bf16(const float* xrow, const float* g, bf16_t* orow, int lane) {
    const f32x4* xr = (const f32x4*)xrow + lane;
    const f32x4* gr = (const f32x4*)g + lane;
    f32x4 v[4]; float s = 0.f;
#pragma unroll
    for (int j = 0; j < 4; ++j) { v[j] = xr[64 * j]; s += (v[j].x * v[j].x + v[j].y * v[j].y) + (v[j].z * v[j].z + v[j].w * v[j].w); }
    const float rs = rsqrtf(wave_sum(s) * (1.0f / DM) + EPS);
    u32x2* o8 = (u32x2*)orow + lane;
#pragma unroll
    for (int j = 0; j < 4; ++j) { const f32x4 gg = gr[64 * j]; u32x2 w; w.x = cvtpk(v[j].x * rs * gg.x, v[j].y * rs * gg.y); w.y = cvtpk(v[j].z * rs * gg.z, v[j].w * rs * gg.w); o8[64 * j] = w; }
}

__device__ __forceinline__ void p0_transpose_item(const float* W, int K, int N, bf16_t* WT, LAS float* scr, int item, int lane, const float* kgain = nullptr) {
    const int nblk = N / 32, kb = item / nblk, nb = item % nblk, k0 = 64 * kb, n0 = 32 * nb;
#pragma unroll 8
    for (int i = 0; i < 32; ++i) { const int kk = 2 * i + (lane >> 5); const float gk = kgain ? kgain[k0 + kk] : 1.0f; scr[kk * 33 + (lane & 31)] = W[(size_t)(k0 + kk) * N + n0 + (lane & 31)] * gk; }
    asm volatile("s_waitcnt lgkmcnt(0)" ::: "memory");
    const int c = lane & 7;
#pragma unroll
    for (int j = 0; j < 4; ++j) { const int n = (lane >> 3) + 8 * j; const LAS float* s = scr + (8 * c) * 33 + n;
        u32x4 o; o.x = cvtpk(s[0 * 33], s[1 * 33]); o.y = cvtpk(s[2 * 33], s[3 * 33]); o.z = cvtpk(s[4 * 33], s[5 * 33]); o.w = cvtpk(s[6 * 33], s[7 * 33]);
        *(u32x4*)(WT + (size_t)(n0 + n) * K + k0 + 8 * c) = o; }
    asm volatile("s_waitcnt lgkmcnt(0)" ::: "memory");
}

struct Ctx {
    LAS unsigned char* lds;
    int tid, lane, wave, vcu, G, gw, NGW;
    const float* const* in; float* out; unsigned char* ws;
};

__device__ __forceinline__ void phase_p0(const Ctx& F) {
    const float* w_in = F.in[2]; const float* w_out = F.in[6]; const float* wq = F.in[8]; const float* keys = F.in[9];
    const float* pu = F.in[10]; const float* pv = F.in[11];
    LAS float* scr = (LAS float*)(F.lds + F.wave * 16384);
    constexpr int I_IN = 16 * 72, I_SQ = 16 * 32, I_L = I_IN + 2 * I_SQ, NIT = 2 * I_L;
    for (int it = F.gw; it < NIT; it += F.NGW) {
        const int l = it / I_L, r = it % I_L;
        if (r < I_IN) p0_transpose_item(w_in + (size_t)l * DM * PW, DM, PW, (bf16_t*)(F.ws + WS_WIN) + (size_t)l * PW * DM, scr, r, F.lane);
        else if (r < I_IN + I_SQ) p0_transpose_item(w_out + (size_t)l * DM * DM, DM, DM, (bf16_t*)(F.ws + WS_WOUT) + (size_t)l * DM * DM, scr, r - I_IN, F.lane);
        else p0_transpose_item(wq + (size_t)l * DM * DM, DM, DM, (bf16_t*)(F.ws + WS_WQ) + (size_t)l * DM * DM, scr, r - I_IN - I_SQ, F.lane, F.in[7] + (size_t)l * DM);
    }
    const int gtid = F.vcu * NTHREADS + F.tid, NT = F.G * NTHREADS;
    for (int i = gtid; i < 262144 / 8; i += NT) {
        const f32x4 a = *(const f32x4*)(keys + (size_t)i * 8), b = *(const f32x4*)(keys + (size_t)i * 8 + 4);
        u32x4 o; o.x = cvtpk(a.x, a.y); o.y = cvtpk(a.z, a.w); o.z = cvtpk(b.x, b.y); o.w = cvtpk(b.z, b.w);
        *(u32x4*)((bf16_t*)(F.ws + WS_KEYS) + (size_t)i * 8) = o;
    }
#pragma unroll 2
    for (int rp = F.gw; rp < 2 * NEXP * 2 / 2; rp += F.NGW) {
        const int row = 2 * rp + (F.lane >> 5), k = F.lane & 31;
        const bool isv = row >= 2 * NEXP; const int rr = isv ? row - 2 * NEXP : row;
        const float* src = (isv ? pv : pu) + (size_t)rr * DM + 4 * k;
        f32x16 a, b;
#pragma unroll
        for (int i = 0; i < 8; ++i) { const f32x4 t = *(const f32x4*)(src + 128 * i); a[2 * i] = t.x; b[2 * i] = t.y; a[2 * i + 1] = t.z; b[2 * i + 1] = t.w; }
        float am = 0.f;
#pragma unroll
        for (int i = 0; i < 16; ++i) am = fmaxf(am, fmaxf(fabsf(a[i]), fabsf(b[i])));
        am = fmaxf(am, dppf<DPP_XOR1>(am)); am = fmaxf(am, dppf<DPP_XOR2>(am)); am = fmaxf(am, dppf<DPP_HMIR>(am)); am = fmaxf(am, dppf<DPP_RMIR>(am)); am = swap16_max(am);
        const float sc = am > 0.f ? exp2f(ceilf(log2f(am * (1.0f / 7.5f)))) : 1.0f, inv = 1.0f / sc;
        a = a * inv; b = b * inv;
        const u32x6 w = __builtin_amdgcn_cvt_scalef32_2xpk16_fp6_f32(a, b, 1.0f);
        *(u32x6_a8*)(F.ws + (isv ? WS_V : WS_U) + (size_t)rr * ROWB + 24 * k) = w;
        if (k == 0) ((float*)(F.ws + (isv ? WS_SV : WS_SU)))[rr] = sc;
    }
    for (int e = gtid; e < 2048 * 64; e += NT) {
        const int pos = e >> 6, i = e & 63;
        float ang;
        if (i < 32) ang = (float)pos * powf(10000.0f, -(float)i / 32.0f);
        else if (i < 48) ang = (float)(pos >> 6) * powf(10000.0f, -(float)(i - 32) / 16.0f);
        else ang = (float)(pos & 63) * powf(10000.0f, -(float)(i - 48) / 16.0f);
        f32x2_t cs; cs.x = cosf(ang); cs.y = sinf(ang);
        ((f32x2_t*)(F.ws + WS_ROPE))[e] = cs;
    }
    for (int m = F.gw; m < MTOK; m += 2 * F.NGW) {
        const int m2 = m + F.NGW;
        const f32x4* xa = (const f32x4*)(F.in[0] + (size_t)m * DM) + F.lane; const f32x4* xb = (const f32x4*)(F.in[0] + (size_t)(m2 < MTOK ? m2 : m) * DM) + F.lane;
        const f32x4* gr = (const f32x4*)F.in[1] + F.lane;
        f32x4 va[4], vb[4]; float sa = 0.f, sb = 0.f;
#pragma unroll
        for (int j = 0; j < 4; ++j) { va[j] = xa[64 * j]; vb[j] = xb[64 * j]; }
#pragma unroll
        for (int j = 0; j < 4; ++j) { sa += (va[j].x * va[j].x + va[j].y * va[j].y) + (va[j].z * va[j].z + va[j].w * va[j].w); sb += (vb[j].x * vb[j].x + vb[j].y * vb[j].y) + (vb[j].z * vb[j].z + vb[j].w * vb[j].w); }
        const float ra = rsqrtf(wave_sum(sa) * (1.0f / DM) + EPS), rb = rsqrtf(wave_sum(sb) * (1.0f / DM) + EPS);
        u32x2* oa = (u32x2*)((bf16_t*)(F.ws + WS_H) + (size_t)m * DM) + F.lane; u32x2* ob = (u32x2*)((bf16_t*)(F.ws + WS_H) + (size_t)(m2 < MTOK ? m2 : m) * DM) + F.lane;
#pragma unroll
        for (int j = 0; j < 4; ++j) { const f32x4 gg = gr[64 * j];
            u32x2 w; w.x = cvtpk(va[j].x * ra * gg.x, va[j].y * ra * gg.y); w.y = cvtpk(va[j].z * ra * gg.z, va[j].w * ra * gg.w); oa[64 * j] = w;
            if (m2 < MTOK) { u32x2 v; v.x = cvtpk(vb[j].x * rb * gg.x, vb[j].y * rb * gg.y); v.y = cvtpk(vb[j].z * rb * gg.z, vb[j].w * rb * gg.w); ob[64 * j] = v; } }
    }
}

__device__ __forceinline__ void phase_norm(const Ctx& F, const float* x, const float* g) {
    for (int m = F.gw; m < MTOK; m += F.NGW) norm_row_to_bf16(x + (size_t)m * DM, g, (bf16_t*)(F.ws + WS_H) + (size_t)m * DM, F.lane);
}

__device__ __forceinline__ void head_info(int hs, int& type, int& gi) {
    if (hs < 6) { type = 1; gi = 0; } else if (hs < 8) { type = 1; gi = 1; } else if (hs < 10) { type = 0; gi = 0; }
    else if (hs < 16) { type = 2; gi = 2; } else if (hs < 22) { type = 2; gi = 3; } else if (hs < 28) { type = 0; gi = 0; }
    else if (hs < 32) { type = 2; gi = 4; } else if (hs < 34) { type = 2; gi = 5; } else { type = 0; gi = 0; }
}
__device__ __forceinline__ void phase_rope(const Ctx& F, const float* gain  ) {
    bf16_t* P = (bf16_t*)(F.ws + WS_P);
    const f32x2_t* tab = (const f32x2_t*)(F.ws + WS_ROPE);
    const int s = F.lane & 7, grp8 = F.lane >> 3;
    const int hs0 = grp8 < 2 ? 6 + grp8 : 14 + grp8, hs1 = grp8 < 2 ? 32 + grp8 : 33;
    if (F.gw >= MTOK) return;
    u32x4 r0 = *(const u32x4*)(P + (size_t)F.gw * PW + hs0 * 64 + s * 8), r1 = *(const u32x4*)(P + (size_t)F.gw * PW + hs1 * 64 + s * 8);
    for (int tok = F.gw; tok < MTOK; tok += F.NGW) {
        const int pos = tok & (SEQ - 1);
        bf16_t* row = P + (size_t)tok * PW;
        const int tn = tok + F.NGW < MTOK ? tok + F.NGW : tok;
        const u32x4 n0 = *(const u32x4*)(P + (size_t)tn * PW + hs0 * 64 + s * 8), n1 = *(const u32x4*)(P + (size_t)tn * PW + hs1 * 64 + s * 8);
#pragma unroll
        for (int pass = 0; pass < 2; ++pass) {
            const int hs = pass == 0 ? hs0 : hs1;
            const bool act = pass == 0 || grp8 < 2;
            int type, gi; head_info(hs, type, gi);
            const u32x4 raw = pass == 0 ? r0 : r1;
            float x[8]; x[0] = bf_lo(raw.x); x[1] = bf_hi(raw.x); x[2] = bf_lo(raw.y); x[3] = bf_hi(raw.y); x[4] = bf_lo(raw.z); x[5] = bf_hi(raw.z); x[6] = bf_lo(raw.w); x[7] = bf_hi(raw.w);
            float ss = 0.f;
#pragma unroll
            for (int e = 0; e < 8; ++e) ss += x[e] * x[e];
            ss += dppf<DPP_XOR1>(ss); ss += dppf<DPP_XOR2>(ss); ss += dppf<DPP_HMIR>(ss);
            const float rs = rsqrtf(ss * (1.0f / 64.0f) + EPS);
            const f32x4 g0 = *(const f32x4*)(gain + gi * 64 + s * 8), g1 = *(const f32x4*)(gain + gi * 64 + s * 8 + 4);
            float y[8]; y[0] = x[0] * rs * g0.x; y[1] = x[1] * rs * g0.y; y[2] = x[2] * rs * g0.z; y[3] = x[3] * rs * g0.w; y[4] = x[4] * rs * g1.x; y[5] = x[5] * rs * g1.y; y[6] = x[6] * rs * g1.z; y[7] = x[7] * rs * g1.w;
            const bool one_d = (type == 2);
            const int tbase = one_d ? 8 * (s & 3) : 32 + (s >> 2) * 16 + 8 * (s & 1);
            const bool isx1 = one_d ? (s < 4) : ((s & 2) == 0);
            float o[8];
#pragma unroll
            for (int e = 0; e < 8; ++e) {
                const float o4 = dppf<DPP_HMIR>(dppf<DPP_XOR3>(y[e])), o2 = dppf<DPP_XOR2>(y[e]);
                const float oth = one_d ? o4 : o2;
                const f32x2_t cs = tab[pos * 64 + tbase + e];
                o[e] = isx1 ? (y[e] * cs.x - oth * cs.y) : (oth * cs.y + y[e] * cs.x);
            }
            if (act) {
                u32x4 w; w.x = cvtpk(o[0], o[1]); w.y = cvtpk(o[2], o[3]); w.z = cvtpk(o[4], o[5]); w.w = cvtpk(o[6], o[7]);
                *(u32x4*)(row + hs * 64 + s * 8) = w;
            }
        }
        r0 = n0; r1 = n1;
    }
}

struct AUnit {
    const bf16_t* q; const bf16_t* k; const bf16_t* v;
    bf16_t* o; float* lse;
    int ostride, btok, r, c, pair, pos0, T0, T1, W, has_sink; float sink2;
    const float* qgain; const f32x2_t* ropetab; int qaxial;
};
constexpr int ATT_KV = 0, ATT_WSF = 32768, ATT_OST = 34816;

__device__ __forceinline__ void attn_unit(const AUnit& U, LAS unsigned char* lds, int tid) {
    const int lane = tid & 63, r32 = lane & 31, hi = lane >> 5; const int wid = __builtin_amdgcn_readfirstlane(tid >> 6);
    const int sub = U.pair ? (wid >> 2) : 0;
    const int ipos0 = U.pair ? 32 * (wid & 3) : U.pos0 + 32 * wid;
    const int myi = ipos0 + r32;
    const int tokq0 = U.btok + U.c + sub;
    int wt0, wt1;
    if (U.pair) { wt0 = 2 * sub; wt1 = wt0 + 2; }
    else if (U.W >= 0) { wt0 = max(U.T0, (ipos0 - U.W) >> 6); wt1 = min(U.T1, ((ipos0 + 31 + U.W) >> 6) + 1); }
    else { wt0 = U.T0; wt1 = U.T1; }
    const int vkey = 16 * (wid & 3) + (lane >> 2);
    const int kcol = wid * 8, vcol = (wid >> 2) * 32 + (lane & 3) * 8;
    const unsigned stoff = (unsigned)wid * 1024u + (unsigned)lane * 16u;
#define ATT_TOK(t, key) (U.pair ? (U.btok + U.c + ((t) >> 1) + (64 * ((t) & 1) + (key)) * 16) : (U.btok + U.c + (64 * (t) + (key)) * U.r))
    LAS float* wsf = (LAS float*)(lds + ATT_WSF) + wid * 64;
    float m = U.has_sink ? U.sink2 : 0.f;
    bool started = U.has_sink != 0;
    f32x16 negm;
#pragma unroll
    for (int r = 0; r < 16; ++r) negm[r] = -m;
    float l = (U.has_sink && hi == 0) ? 1.0f : 0.0f;
    f32x16 o0 = {}, o1 = {};
    u32x4 kA, vA, kB, vB;
#define ATT_LD(KR, VR, tt) do { const int t__ = min((tt), U.T1 - 1); KR = *(const u32x4*)(U.k + (size_t)ATT_TOK(t__, lane) * PW + kcol); VR = *(const u32x4*)(U.v + (size_t)ATT_TOK(t__, vkey) * PW + vcol); } while (0)
#define ATT_ST(bufi, KR, VR) do { *(LAS u32x4*)(lds + ATT_KV + (bufi) * 16384 + stoff) = KR; *(LAS u32x4*)(lds + ATT_KV + (bufi) * 16384 + 8192 + stoff) = VR; } while (0)
    ATT_LD(kA, vA, U.T0);
    bf16x8 qr[4];
    {   const int qtok = tokq0 + myi * U.r, pos = qtok & (SEQ - 1);
        const bf16_t* qp = U.q + (size_t)qtok * PW + hi * 8;
        float y[4][8]; float ss = 0.f;
#pragma unroll
        for (int d0 = 0; d0 < 4; ++d0) { const u32x4 raw = *(const u32x4*)(qp + d0 * 16);
            y[d0][0] = bf_lo(raw.x); y[d0][1] = bf_hi(raw.x); y[d0][2] = bf_lo(raw.y); y[d0][3] = bf_hi(raw.y); y[d0][4] = bf_lo(raw.z); y[d0][5] = bf_hi(raw.z); y[d0][6] = bf_lo(raw.w); y[d0][7] = bf_hi(raw.w);
#pragma unroll
            for (int j = 0; j < 8; ++j) ss += y[d0][j] * y[d0][j]; }
        ss = swap32_sum(ss, ss);
        const float rs = rsqrtf(ss * (1.0f / 64.0f) + EPS);
#pragma unroll
        for (int d0 = 0; d0 < 4; ++d0) { const f32x4 g0 = *(const f32x4*)(U.qgain + d0 * 16 + hi * 8), g1 = *(const f32x4*)(U.qgain + d0 * 16 + hi * 8 + 4);
            y[d0][0] *= rs * g0.x; y[d0][1] *= rs * g0.y; y[d0][2] *= rs * g0.z; y[d0][3] *= rs * g0.w; y[d0][4] *= rs * g1.x; y[d0][5] *= rs * g1.y; y[d0][6] *= rs * g1.z; y[d0][7] *= rs * g1.w; }
        const f32x2_t* tab = U.ropetab + (size_t)pos * 64;
        float z[4][8];
        if (U.qaxial) {
#pragma unroll
            for (int hf2 = 0; hf2 < 2; ++hf2)
#pragma unroll
                for (int j = 0; j < 8; ++j) { const f32x2_t cs = tab[32 + hf2 * 16 + 8 * hi + j]; const float x1 = y[2 * hf2][j], x2 = y[2 * hf2 + 1][j];
                    z[2 * hf2][j] = x1 * cs.x - x2 * cs.y; z[2 * hf2 + 1][j] = x1 * cs.y + x2 * cs.x; }
        } else {
#pragma unroll
            for (int d0 = 0; d0 < 2; ++d0)
#pragma unroll
                for (int j = 0; j < 8; ++j) { const f32x2_t cs = tab[16 * d0 + 8 * hi + j]; const float x1 = y[d0][j], x2 = y[d0 + 2][j];
                    z[d0][j] = x1 * cs.x - x2 * cs.y; z[d0 + 2][j] = x1 * cs.y + x2 * cs.x; }
        }
#pragma unroll
        for (int d0 = 0; d0 < 4; ++d0) { u32x4 w; w.x = cvtpk(z[d0][0] * QSCALE, z[d0][1] * QSCALE); w.y = cvtpk(z[d0][2] * QSCALE, z[d0][3] * QSCALE); w.z = cvtpk(z[d0][4] * QSCALE, z[d0][5] * QSCALE); w.w = cvtpk(z[d0][6] * QSCALE, z[d0][7] * QSCALE);
            qr[d0] = __builtin_bit_cast(bf16x8, w); }
    }
    ATT_ST(0, kA, vA);
    __syncthreads();
    ATT_LD(kA, vA, U.T0 + 1);
    for (int t = U.T0; t < U.T1; t += 2) {
        ATT_LD(kB, vB, t + 2);
        { const int TT = t; constexpr int CUR = 0;
        if (TT >= wt0 && TT < wt1) {
            LAS const unsigned char* kb = lds + ATT_KV + CUR * 16384 + hi * 1024 + r32 * 16;
            LAS const unsigned char* vp = lds + ATT_KV + CUR * 16384 + 8192 + ((lane >> 4) & 1) * 32 + (lane & 3) * 8 + (4 * hi + ((lane & 15) >> 2)) * 64;
            bf16x8 kf[8];
#pragma unroll
            for (int d0 = 0; d0 < 4; ++d0) { kf[2 * d0] = *(LAS const bf16x8*)(kb + d0 * 2048); kf[2 * d0 + 1] = *(LAS const bf16x8*)(kb + d0 * 2048 + 512); }
            s16x4 vlo[8], vhi[8];
#define ATT_TR(off) __builtin_bit_cast(s16x4, __builtin_amdgcn_ds_read_tr16_b64_v4i16((LAS s16x4*)(vp + (off))))
#pragma unroll
            for (int i = 0; i < 8; ++i) { vlo[i] = ATT_TR((i >> 2) * 4096 + (i & 3) * 1024); vhi[i] = ATT_TR((i >> 2) * 4096 + (i & 3) * 1024 + 512); }
#undef ATT_TR
            f32x16 p0 = negm, p1 = negm;
#pragma unroll
            for (int d0 = 0; d0 < 4; ++d0) {
                p0 = __builtin_amdgcn_mfma_f32_32x32x16_bf16(kf[2 * d0], qr[d0], p0, 0, 0, 0);
                p1 = __builtin_amdgcn_mfma_f32_32x32x16_bf16(kf[2 * d0 + 1], qr[d0], p1, 0, 0, 0);
            }
            if (U.W >= 0) {
                const int jb = (U.pair ? 64 * (TT & 1) : 64 * TT) + 4 * hi;
                const int lo = myi - U.W - jb; const unsigned span = 2u * (unsigned)U.W;
#pragma unroll
                for (int r = 0; r < 16; ++r) {
                    const int jr = (r & 3) + 8 * (r >> 2);
                    if ((unsigned)(jr - lo) > span) p0[r] = -INFINITY;
                    if ((unsigned)(jr + 32 - lo) > span) p1[r] = -INFINITY;
                }
            }
            float mx = fmaxf(p0[0], p1[0]);
#pragma unroll
            for (int r = 1; r < 16; ++r) mx = fmax3(mx, p0[r], p1[r]);
            { auto rr = __builtin_amdgcn_permlane32_swap(__float_as_uint(mx), __float_as_uint(mx), false, false); mx = fmaxf(__uint_as_float(rr[0]), __uint_as_float(rr[1])); }
            if (!started || __any(mx > 8.0f)) {
                float dl = started ? fmaxf(mx, 0.f) : mx;
                if (dl == -INFINITY) dl = 0.f;
                m += dl;
#pragma unroll
                for (int r = 0; r < 16; ++r) { p0[r] -= dl; p1[r] -= dl; negm[r] = -m; }
                if (started) {
                    const float alpha = __builtin_amdgcn_exp2f(-dl);
                    l *= alpha;
                    if (hi == 0) wsf[r32] = alpha;
#pragma unroll
                    for (int r = 0; r < 16; ++r) { const float a = wsf[crow(r, hi)]; o0[r] *= a; o1[r] *= a; }
                }
                started = true;
            }
            float rsum = 0.f;
#pragma unroll
            for (int r = 0; r < 16; ++r) { p0[r] = __builtin_amdgcn_exp2f(p0[r]); p1[r] = __builtin_amdgcn_exp2f(p1[r]); rsum += p0[r] + p1[r]; }
            l += rsum;
            u32x4 pw0, pw1, pw2, pw3;
            pw0.x = cvtpk(p0[0], p0[1]); pw0.y = cvtpk(p0[2], p0[3]); pw0.z = cvtpk(p0[4], p0[5]); pw0.w = cvtpk(p0[6], p0[7]);
            pw1.x = cvtpk(p0[8], p0[9]); pw1.y = cvtpk(p0[10], p0[11]); pw1.z = cvtpk(p0[12], p0[13]); pw1.w = cvtpk(p0[14], p0[15]);
            pw2.x = cvtpk(p1[0], p1[1]); pw2.y = cvtpk(p1[2], p1[3]); pw2.z = cvtpk(p1[4], p1[5]); pw2.w = cvtpk(p1[6], p1[7]);
            pw3.x = cvtpk(p1[8], p1[9]); pw3.y = cvtpk(p1[10], p1[11]); pw3.z = cvtpk(p1[12], p1[13]); pw3.w = cvtpk(p1[14], p1[15]);
#define ATT_VF(i) (bf16x8){vlo[i][0], vlo[i][1], vlo[i][2], vlo[i][3], vhi[i][0], vhi[i][1], vhi[i][2], vhi[i][3]}
            o0 = __builtin_amdgcn_mfma_f32_32x32x16_bf16(__builtin_bit_cast(bf16x8, pw0), ATT_VF(0), o0, 0, 0, 0);
            o1 = __builtin_amdgcn_mfma_f32_32x32x16_bf16(__builtin_bit_cast(bf16x8, pw0), ATT_VF(4), o1, 0, 0, 0);
            o0 = __builtin_amdgcn_mfma_f32_32x32x16_bf16(__builtin_bit_cast(bf16x8, pw1), ATT_VF(1), o0, 0, 0, 0);
            o1 = __builtin_amdgcn_mfma_f32_32x32x16_bf16(__builtin_bit_cast(bf16x8, pw1), ATT_VF(5), o1, 0, 0, 0);
            o0 = __builtin_amdgcn_mfma_f32_32x32x16_bf16(__builtin_bit_cast(bf16x8, pw2), ATT_VF(2), o0, 0, 0, 0);
            o1 = __builtin_amdgcn_mfma_f32_32x32x16_bf16(__builtin_bit_cast(bf16x8, pw2), ATT_VF(6), o1, 0, 0, 0);
            o0 = __builtin_amdgcn_mfma_f32_32x32x16_bf16(__builtin_bit_cast(bf16x8, pw3), ATT_VF(3), o0, 0, 0, 0);
            o1 = __builtin_amdgcn_mfma_f32_32x32x16_bf16(__builtin_bit_cast(bf16x8, pw3), ATT_VF(7), o1, 0, 0, 0);
#undef ATT_VF
        }
        }
        if (t + 1 < U.T1) ATT_ST(1, kA, vA);
        __syncthreads();
        if (t + 1 >= U.T1) break;
        ATT_LD(kA, vA, t + 3);
        { const int TT = t + 1; constexpr int CUR = 1;
        if (TT >= wt0 && TT < wt1) {
            LAS const unsigned char* kb = lds + ATT_KV + CUR * 16384 + hi * 1024 + r32 * 16;
            LAS const unsigned char* vp = lds + ATT_KV + CUR * 16384 + 8192 + ((lane >> 4) & 1) * 32 + (lane & 3) * 8 + (4 * hi + ((lane & 15) >> 2)) * 64;
            bf16x8 kf[8];
#pragma unroll
            for (int d0 = 0; d0 < 4; ++d0) { kf[2 * d0] = *(LAS const bf16x8*)(kb + d0 * 2048); kf[2 * d0 + 1] = *(LAS const bf16x8*)(kb + d0 * 2048 + 512); }
            s16x4 vlo[8], vhi[8];
#define ATT_TR(off) __builtin_bit_cast(s16x4, __builtin_amdgcn_ds_read_tr16_b64_v4i16((LAS s16x4*)(vp + (off))))
#pragma unroll
            for (int i = 0; i < 8; ++i) { vlo[i] = ATT_TR((i >> 2) * 4096 + (i & 3) * 1024); vhi[i] = ATT_TR((i >> 2) * 4096 + (i & 3) * 1024 + 512); }
#undef ATT_TR
            f32x16 p0 = negm, p1 = negm;
#pragma unroll
            for (int d0 = 0; d0 < 4; ++d0) {
                p0 = __builtin_amdgcn_mfma_f32_32x32x16_bf16(kf[2 * d0], qr[d0], p0, 0, 0, 0);
                p1 = __builtin_amdgcn_mfma_f32_32x32x16_bf16(kf[2 * d0 + 1], qr[d0], p1, 0, 0, 0);
            }
            if (U.W >= 0) {
                const int jb = (U.pair ? 64 * (TT & 1) : 64 * TT) + 4 * hi;
                const int lo = myi - U.W - jb; const unsigned span = 2u * (unsigned)U.W;
#pragma unroll
                for (int r = 0; r < 16; ++r) {
                    const int jr = (r & 3) + 8 * (r >> 2);
                    if ((unsigned)(jr - lo) > span) p0[r] = -INFINITY;
                    if ((unsigned)(jr + 32 - lo) > span) p1[r] = -INFINITY;
                }
            }
            float mx = fmaxf(p0[0], p1[0]);
#pragma unroll
            for (int r = 1; r < 16; ++r) mx = fmax3(mx, p0[r], p1[r]);
            { auto rr = __builtin_amdgcn_permlane32_swap(__float_as_uint(mx), __float_as_uint(mx), false, false); mx = fmaxf(__uint_as_float(rr[0]), __uint_as_float(rr[1])); }
            if (!started || __any(mx > 8.0f)) {
                float dl = started ? fmaxf(mx, 0.f) : mx;
                if (dl == -INFINITY) dl = 0.f;
                m += dl;
#pragma unroll
                for (int r = 0; r < 16; ++r) { p0[r] -= dl; p1[r] -= dl; negm[r] = -m; }
                if (started) {
                    const float alpha = __builtin_amdgcn_exp2f(-dl);
                    l *= alpha;
                    if (hi == 0) wsf[r32] = alpha;
#pragma unroll
                    for (int r = 0; r < 16; ++r) { const float a = wsf[crow(r, hi)]; o0[r] *= a; o1[r] *= a; }
                }
                started = true;
            }
            float rsum = 0.f;
#pragma unroll
            for (int r = 0; r < 16; ++r) { p0[r] = __builtin_amdgcn_exp2f(p0[r]); p1[r] = __builtin_amdgcn_exp2f(p1[r]); rsum += p0[r] + p1[r]; }
            l += rsum;
            u32x4 pw0, pw1, pw2, pw3;
            pw0.x = cvtpk(p0[0], p0[1]); pw0.y = cvtpk(p0[2], p0[3]); pw0.z = cvtpk(p0[4], p0[5]); pw0.w = cvtpk(p0[6], p0[7]);
            pw1.x = cvtpk(p0[8], p0[9]); pw1.y = cvtpk(p0[10], p0[11]); pw1.z = cvtpk(p0[12], p0[13]); pw1.w = cvtpk(p0[14], p0[15]);
            pw2.x = cvtpk(p1[0], p1[1]); pw2.y = cvtpk(p1[2], p1[3]); pw2.z = cvtpk(p1[4], p1[5]); pw2.w = cvtpk(p1[6], p1[7]);
            pw3.x = cvtpk(p1[8], p1[9]); pw3.y = cvtpk(p1[10], p1[11]); pw3.z = cvtpk(p1[12], p1[13]); pw3.w = cvtpk(p1[14], p1[15]);
#define ATT_VF(i) (bf16x8){vlo[i][0], vlo[i][1], vlo[i][2], vlo[i][3], vhi[i][0], vhi[i][1], vhi[i][2], vhi[i][3]}
            o0 = __builtin_amdgcn_mfma_f32_32x32x16_bf16(__builtin_bit_cast(bf16x8, pw0), ATT_VF(0), o0, 0, 0, 0);
            o1 = __builtin_amdgcn_mfma_f32_32x32x16_bf16(__builtin_bit_cast(bf16x8, pw0), ATT_VF(4), o1, 0, 0, 0);
            o0 = __builtin_amdgcn_mfma_f32_32x32x16_bf16(__builtin_bit_cast(bf16x8, pw1), ATT_VF(1), o0, 0, 0, 0);
            o1 = __builtin_amdgcn_mfma_f32_32x32x16_bf16(__builtin_bit_cast(bf16x8, pw1), ATT_VF(5), o1, 0, 0, 0);
            o0 = __builtin_amdgcn_mfma_f32_32x32x16_bf16(__builtin_bit_cast(bf16x8, pw2), ATT_VF(2), o0, 0, 0, 0);
            o1 = __builtin_amdgcn_mfma_f32_32x32x16_bf16(__builtin_bit_cast(bf16x8, pw2), ATT_VF(6), o1, 0, 0, 0);
            o0 = __builtin_amdgcn_mfma_f32_32x32x16_bf16(__builtin_bit_cast(bf16x8, pw3), ATT_VF(3), o0, 0, 0, 0);
            o1 = __builtin_amdgcn_mfma_f32_32x32x16_bf16(__builtin_bit_cast(bf16x8, pw3), ATT_VF(7), o1, 0, 0, 0);
#undef ATT_VF
        }
        }
        if (t + 2 < U.T1) ATT_ST(0, kB, vB);
        __syncthreads();
    }
#undef ATT_LD
#undef ATT_ST
#undef ATT_TOK
    float ltot;
    { auto rr = __builtin_amdgcn_permlane32_swap(__float_as_uint(l), __float_as_uint(l), false, false); ltot = __uint_as_float(rr[0]) + __uint_as_float(rr[1]); }
    if (hi == 0) wsf[r32] = 1.0f / ltot;
    LAS bf16_t* stg = (LAS bf16_t*)(lds + ATT_OST) + wid * 2048;
#pragma unroll
    for (int r = 0; r < 16; ++r) {
        const int orow = crow(r, hi); const float rl = wsf[orow];
        stg[orow * 64 + r32] = (bf16_t)(cvtpk(o0[r] * rl, 0.f) & 0xffffu);
        stg[orow * 64 + 32 + r32] = (bf16_t)(cvtpk(o1[r] * rl, 0.f) & 0xffffu);
    }
#pragma unroll
    for (int i = 0; i < 4; ++i) {
        const int row = i * 8 + (lane >> 3), ch = lane & 7;
        const u32x4 v = *(LAS const u32x4*)(stg + row * 64 + ch * 8);
        *(u32x4*)(U.o + (size_t)(tokq0 + (ipos0 + row) * U.r) * U.ostride + ch * 8) = v;
    }
    if (U.lse != nullptr && hi == 0) U.lse[(size_t)(tokq0 + myi * U.r) * 6] = m + __builtin_amdgcn_logf(ltot);
}

__device__ __forceinline__ void phase_attn(const Ctx& F, const float* sink  , const float* gain  ) {
    const bf16_t* P = (const bf16_t*)(F.ws + WS_P);
    bf16_t* MIX = (bf16_t*)(F.ws + WS_MIX); bf16_t* OB = (bf16_t*)(F.ws + WS_OB); float* LSE = (float*)(F.ws + WS_LSE);
    constexpr int NU = 768 * 4 + 512;
    for (int u = F.vcu; u < NU; u += F.G) {
        AUnit U; U.lse = nullptr; U.r = 1; U.c = 0; U.pair = 0; U.W = -1; U.has_sink = 0; U.sink2 = 0.f; U.ropetab = (const f32x2_t*)(F.ws + WS_ROPE);
        if (u < 768) {
            const int b = u / 48, h = (u >> 3) % 6, qb = u & 7;
            U.q = P + C_QA + h * 64; U.k = P + C_KA + (h / 3) * 64; U.v = P + C_VA + (h / 3) * 64; U.o = MIX + h * 64; U.ostride = DM;
            U.btok = b * SEQ; U.pos0 = 256 * qb; U.T0 = 0; U.T1 = 32; U.qgain = gain; U.qaxial = 1;
        } else if (u < 3072) {
            const int br = (u - 768) / 768, uu = (u - 768) % 768;
            const int b = uu / 48, h = (uu >> 3) % 6, x = uu & 7;
            U.q = P + C_QB + h * 64; U.k = P + C_KB + h * 64; U.v = P + C_VB + h * 64; U.o = OB + (size_t)br * MTOK * 384 + h * 64; U.ostride = 384;
            U.lse = LSE + (size_t)br * MTOK * 6 + h; U.btok = b * SEQ; U.W = 64; U.qgain = gain + 2 * 64; U.qaxial = 0;
            if (br == 0) { U.pos0 = 256 * x; U.T0 = max(0, 4 * x - 1); U.T1 = min(32, 4 * x + 5); }
            else if (br == 1) { const int qb = x & 1; U.r = 4; U.c = x >> 1; U.pos0 = 256 * qb; U.T0 = max(0, 4 * qb - 1); U.T1 = min(8, 4 * qb + 5); }
            else { U.r = 16; U.c = 2 * x; U.pair = 1; U.pos0 = 0; U.T0 = 0; U.T1 = 4; }
        } else {
            const int uu = u - 3072; const int b = uu / 32, h = (uu >> 3) & 3, qb = uu & 7;
            U.q = P + C_QC + h * 64; U.k = P + C_KC + (h >> 1) * 64; U.v = P + C_VC + (h >> 1) * 64; U.o = MIX + 768 + h * 64; U.ostride = DM;
            U.btok = b * SEQ; U.pos0 = 256 * qb; U.W = 128; U.T0 = max(0, 4 * qb - 2); U.T1 = min(32, 4 * qb + 6);
            U.has_sink = 1; U.sink2 = sink[h] * LOG2E; U.qgain = gain + 4 * 64; U.qaxial = 0;
        }
        attn_unit(U, F.lds, F.tid);
    }
}

__device__ __forceinline__ void unpack8(const u32x4 w, float (&x)[8]) { x[0] = bf_lo(w.x); x[1] = bf_hi(w.x); x[2] = bf_lo(w.y); x[3] = bf_hi(w.y); x[4] = bf_lo(w.z); x[5] = bf_hi(w.z); x[6] = bf_lo(w.w); x[7] = bf_hi(w.w); }
struct PostRaw { u32x4 a, c, t0, t1, t2; float ls0, ls1, ls2; };
__device__ __forceinline__ void post_load(PostRaw& R, const bf16_t* MIX, const bf16_t* OB, const float* LSE, int tok, int l48, int l32) {
    R.a = *(const u32x4*)(MIX + (size_t)tok * DM + l48 * 8); R.c = *(const u32x4*)(MIX + (size_t)tok * DM + 768 + l32 * 8);
    const int h = l48 >> 3;
    R.ls0 = LSE[(size_t)tok * 6 + h]; R.ls1 = LSE[(size_t)(MTOK + tok) * 6 + h]; R.ls2 = LSE[(size_t)(2 * MTOK + tok) * 6 + h];
    R.t0 = *(const u32x4*)(OB + (size_t)tok * 384 + l48 * 8); R.t1 = *(const u32x4*)(OB + (size_t)(MTOK + tok) * 384 + l48 * 8); R.t2 = *(const u32x4*)(OB + (size_t)(2 * MTOK + tok) * 384 + l48 * 8);
}
__device__ __forceinline__ void phase_post(const Ctx& F, const float* g  ) {
    const bf16_t* MIX = (const bf16_t*)(F.ws + WS_MIX); const bf16_t* OB = (const bf16_t*)(F.ws + WS_OB); const float* LSE = (const float*)(F.ws + WS_LSE);
    bf16_t* H = (bf16_t*)(F.ws + WS_H);
    const int lane = F.lane; const int l48 = lane < 48 ? lane : 47, l32 = lane < 32 ? lane : 31;
    if (F.gw >= MTOK) return;
    PostRaw R; post_load(R, MIX, OB, LSE, F.gw, l48, l32);
    for (int tok = F.gw; tok < MTOK; tok += F.NGW) {
        PostRaw N; const int tn = tok + F.NGW;
        post_load(N, MIX, OB, LSE, tn < MTOK ? tn : tok, l48, l32);
        float a[8], bsum[8], c[8];
        unpack8(R.a, a); unpack8(R.c, c);
        const float mxl = fmax3(R.ls0, R.ls1, R.ls2);
        float w0 = __builtin_amdgcn_exp2f(R.ls0 - mxl), w1 = __builtin_amdgcn_exp2f(R.ls1 - mxl), w2 = __builtin_amdgcn_exp2f(R.ls2 - mxl);
        const float inv = 1.0f / (w0 + w1 + w2); w0 *= inv; w1 *= inv; w2 *= inv;
        { float t0[8], t1[8], t2[8];
          unpack8(R.t0, t0); unpack8(R.t1, t1); unpack8(R.t2, t2);
#pragma unroll
          for (int e = 0; e < 8; ++e) bsum[e] = w0 * t0[e] + w1 * t1[e] + w2 * t2[e]; }
        float sa = 0.f, sb = 0.f, sc = 0.f;
#pragma unroll
        for (int e = 0; e < 8; ++e) { sa += a[e] * a[e]; sb += bsum[e] * bsum[e]; sc += c[e] * c[e]; }
        if (lane >= 48) { sa = 0.f; sb = 0.f; }
        if (lane >= 32) sc = 0.f;
        sa = wave_sum(sa); sb = wave_sum(sb); sc = wave_sum(sc);
        const float ra = rsqrtf(sa * (1.0f / 384.0f) + EPS), rb = rsqrtf(sb * (1.0f / 384.0f) + EPS), rc = rsqrtf(sc * (1.0f / 256.0f) + EPS);
        if (lane < 48) {
            const f32x4 g0 = *(const f32x4*)(g + lane * 8), g1 = *(const f32x4*)(g + lane * 8 + 4);
            u32x4 w; w.x = cvtpk(a[0] * ra * g0.x, a[1] * ra * g0.y); w.y = cvtpk(a[2] * ra * g0.z, a[3] * ra * g0.w); w.z = cvtpk(a[4] * ra * g1.x, a[5] * ra * g1.y); w.w = cvtpk(a[6] * ra * g1.z, a[7] * ra * g1.w);
            *(u32x4*)(H + (size_t)tok * DM + lane * 8) = w;
            const f32x4 h0 = *(const f32x4*)(g + 384 + lane * 8), h1 = *(const f32x4*)(g + 384 + lane * 8 + 4);
            u32x4 v; v.x = cvtpk(bsum[0] * rb * h0.x, bsum[1] * rb * h0.y); v.y = cvtpk(bsum[2] * rb * h0.z, bsum[3] * rb * h0.w); v.z = cvtpk(bsum[4] * rb * h1.x, bsum[5] * rb * h1.y); v.w = cvtpk(bsum[6] * rb * h1.z, bsum[7] * rb * h1.w);
            *(u32x4*)(H + (size_t)tok * DM + 384 + lane * 8) = v;
        }
        if (lane < 32) {
            const f32x4 g0 = *(const f32x4*)(g + 768 + lane * 8), g1 = *(const f32x4*)(g + 768 + lane * 8 + 4);
            u32x4 w; w.x = cvtpk(c[0] * rc * g0.x, c[1] * rc * g0.y); w.y = cvtpk(c[2] * rc * g0.z, c[3] * rc * g0.w); w.z = cvtpk(c[4] * rc * g1.x, c[5] * rc * g1.y); w.w = cvtpk(c[6] * rc * g1.z, c[7] * rc * g1.w);
            *(u32x4*)(H + (size_t)tok * DM + 768 + lane * 8) = w;
        }
        R = N;
    }
}

__device__ __forceinline__ float vmaxr(float a, float b) { float r; asm("v_max_f32_e32 %0, %1, %2" : "=v"(r) : "v"(a), "v"(b)); return r; }
__device__ __forceinline__ float vminr(float a, float b) { float r; asm("v_min_f32_e32 %0, %1, %2" : "=v"(r) : "v"(a), "v"(b)); return r; }
#define CEX_D(a, b) do { const float hi_ = vmaxr(a, b), lo_ = vminr(a, b); a = hi_; b = lo_; } while (0)
template <int N> __device__ __forceinline__ void bitonic_sort_desc(float (&v)[N]) {
#pragma unroll
    for (int k = 2; k <= N; k <<= 1)
#pragma unroll
        for (int j = k >> 1; j > 0; j >>= 1)
#pragma unroll
            for (int i = 0; i < N; ++i) { const int l = i ^ j; if (l > i) { if ((i & k) == 0) CEX_D(v[i], v[l]); else CEX_D(v[l], v[i]); } }
}
__device__ __forceinline__ void bitonic_merge16_desc(float (&v)[16]) {
#pragma unroll
    for (int j = 8; j > 0; j >>= 1)
#pragma unroll
        for (int i = 0; i < 16; ++i) { const int l = i ^ j; if (l > i) CEX_D(v[i], v[l]); }
}
template <bool SWAP16> __device__ __forceinline__ void merge_partner16(float (&a)[16]) {
    float e[16], o[16];
#pragma unroll
    for (int i = 0; i < 16; ++i) {
        if (SWAP16) { auto r = __builtin_amdgcn_permlane16_swap(__float_as_uint(a[i]), __float_as_uint(a[i]), false, false); e[i] = __uint_as_float(r[0]); o[i] = __uint_as_float(r[1]); }
        else { auto r = __builtin_amdgcn_permlane32_swap(__float_as_uint(a[i]), __float_as_uint(a[i]), false, false); e[i] = __uint_as_float(r[0]); o[i] = __uint_as_float(r[1]); }
    }
#pragma unroll
    for (int i = 0; i < 16; ++i) a[i] = vmaxr(e[i], o[15 - i]);
    bitonic_merge16_desc(a);
}
__device__ __forceinline__ void phase_route(const Ctx& F, int layer) {
    const bf16_t* Q = (const bf16_t*)(F.ws + WS_Q);
    const bf16_t* KEYS = (const bf16_t*)(F.ws + WS_KEYS) + (size_t)layer * 8 * 2 * 128 * 64;
    unsigned short* IDX = (unsigned short*)(F.ws + WS_IDX); float* GATE = (float*)(F.ws + WS_GATE);
    const float* SSQ = (const float*)(F.ws + WS_SSQ) + (size_t)layer * MTOK * 16;
    const int lane = F.lane, c = lane & 15, g = lane >> 4;
    const int krow = F.wave * 16 + (lane >> 3), kch = lane & 7;
    const unsigned kw0 = (unsigned)krow * 128u + (unsigned)((kch ^ ((krow >> 1) & 7)) << 4), kw1 = (unsigned)(krow + 8) * 128u + (unsigned)((kch ^ (((krow + 8) >> 1) & 7)) << 4);
    const unsigned kra = (unsigned)c * 128u, ksw = (unsigned)((c >> 1) & 7);
    for (int ub = F.vcu * NWAVES; ub < MTOK / 16; ub += F.NGW) {
        const int unit = ub + F.wave;
        const int tok = unit * 16 + c;
        const bf16_t* qrow = Q + (size_t)tok * DM + g * 8;
        float ssq_; { const f32x4 t4 = *(const f32x4*)(SSQ + (size_t)tok * 16 + 4 * g); ssq_ = (t4.x + t4.y) + (t4.z + t4.w); ssq_ = swap16_sum(ssq_, ssq_); ssq_ = swap32_sum(ssq_, ssq_); }
        const float rsl = rsqrtf(ssq_ * (1.0f / DM) + EPS) * LOG2E;
        u32x4 kp0, kp1;
        { const bf16_t* ks = KEYS + (size_t)krow * 64 + kch * 8; kp0 = *(const u32x4*)ks; kp1 = *(const u32x4*)(ks + 8 * 64); }
        __syncthreads();
        *(LAS u32x4*)(F.lds + kw0) = kp0; *(LAS u32x4*)(F.lds + kw1) = kp1;
        __syncthreads();
#pragma unroll 1
        for (int h = 0; h < 8; ++h) {
            float sv0[16], sv1[16];
#pragma unroll
            for (int p = 0; p < 2; ++p) {
                const int hp = h * 2 + p;
                if (hp + 1 < 16) { const bf16_t* ks = KEYS + (size_t)((hp + 1) * 128 + krow) * 64 + kch * 8; kp0 = *(const u32x4*)ks; kp1 = *(const u32x4*)(ks + 8 * 64); }
                const bf16x8 bq0 = *(const bf16x8*)(qrow + h * 128 + p * 64), bq1 = *(const bf16x8*)(qrow + h * 128 + p * 64 + 32);
                LAS const unsigned char* kb = F.lds + p * 16384 + kra;
                float va[16], vb[16];
#pragma unroll
                for (int kt = 0; kt < 8; ++kt) {
                    const bf16x8 a0 = *(LAS const bf16x8*)(kb + kt * 2048 + (((unsigned)g ^ ksw) << 4)), a1 = *(LAS const bf16x8*)(kb + kt * 2048 + (((unsigned)(4 + g) ^ ksw) << 4));
                    f32x4 acc = {0.f, 0.f, 0.f, 0.f};
                    acc = __builtin_amdgcn_mfma_f32_16x16x32_bf16(a0, bq0, acc, 0, 0, 0);
                    acc = __builtin_amdgcn_mfma_f32_16x16x32_bf16(a1, bq1, acc, 0, 0, 0);
#pragma unroll
                    for (int r = 0; r < 4; ++r) { const float x = __uint_as_float((__float_as_uint(acc[r]) & 0xFFFFFF80u) | (unsigned)(kt * 16 + r) | (unsigned)(4 * g));
                        if (kt < 4) va[kt * 4 + r] = x; else vb[(kt - 4) * 4 + r] = x; }
                }
                if (hp + 1 < 16) { *(LAS u32x4*)(F.lds + (1 - p) * 16384 + kw0) = kp0; *(LAS u32x4*)(F.lds + (1 - p) * 16384 + kw1) = kp1; }
                __syncthreads();
                bitonic_sort_desc<16>(va); bitonic_sort_desc<16>(vb);
#pragma unroll
                for (int i = 0; i < 16; ++i) va[i] = vmaxr(va[i], vb[15 - i]);
                bitonic_merge16_desc(va);
                merge_partner16<true>(va); merge_partner16<false>(va);
#pragma unroll
                for (int i = 0; i < 16; ++i) { if (p == 0) sv0[i] = va[i]; else sv1[i] = va[i]; }
            }
            float t[4];
#pragma unroll
            for (int j = 0; j < 4; ++j) t[j] = (g == 0) ? sv1[4 * j] : (g == 1) ? sv1[4 * j + 1] : (g == 2) ? sv1[4 * j + 2] : sv1[4 * j + 3];
#define CANDV(a, j) __uint_as_float((__float_as_uint(sv0[a] + t[j]) & 0xFFFFC000u) | ((__float_as_uint(sv0[a]) & 0x7Fu) << 7) | (__float_as_uint(t[j]) & 0x7Fu))
            float w[16];
#pragma unroll
            for (int a = 0; a < 16; ++a) w[a] = CANDV(a, 0);
            {
                float x0 = CANDV(0, 1), x1 = CANDV(1, 1), x2 = CANDV(2, 1), x3 = CANDV(0, 2), x4 = CANDV(0, 3);
                CEX_D(x0, x1); CEX_D(x3, x4); CEX_D(x2, x4); CEX_D(x2, x3); CEX_D(x0, x3); CEX_D(x0, x2); CEX_D(x1, x4); CEX_D(x1, x3); CEX_D(x1, x2);
                w[15] = vmaxr(w[15], x0); w[14] = vmaxr(w[14], x1); w[13] = vmaxr(w[13], x2); w[12] = vmaxr(w[12], x3); w[11] = vmaxr(w[11], x4);
                bitonic_merge16_desc(w);
            }
#undef CANDV
            merge_partner16<true>(w); merge_partner16<false>(w);
            float e[16]; float den = 0.f;
#pragma unroll
            for (int k = 0; k < 16; ++k) { e[k] = __builtin_amdgcn_exp2f((w[k] - w[0]) * rsl); den += e[k]; }
            const float inv = 1.0f / den;
            if (g == 0) {
                unsigned iw[8];
#pragma unroll
                for (int k = 0; k < 8; ++k) iw[k] = (__float_as_uint(w[2 * k]) & 0x3FFFu) | ((__float_as_uint(w[2 * k + 1]) & 0x3FFFu) << 16);
                u32x4* ip = (u32x4*)(IDX + (size_t)tok * 128 + h * 16);
                ip[0] = (u32x4){iw[0], iw[1], iw[2], iw[3]}; ip[1] = (u32x4){iw[4], iw[5], iw[6], iw[7]};
                f32x4* gp = (f32x4*)(GATE + (size_t)tok * 128 + h * 16);
#pragma unroll
                for (int k = 0; k < 4; ++k) gp[k] = (f32x4){e[4 * k] * inv, e[4 * k + 1] * inv, e[4 * k + 2] * inv, e[4 * k + 3] * inv};
            }
        }
    }
}

template <int PART>
__device__ __forceinline__ void phase_gather(const Ctx& F, int layer) {
    const unsigned char* Ut = F.ws + WS_U + (size_t)layer * NEXP * ROWB;
    const unsigned char* Vt = F.ws + WS_V + (size_t)layer * NEXP * ROWB;
    const float* SU = (const float*)(F.ws + WS_SU) + (size_t)layer * NEXP; const float* SV = (const float*)(F.ws + WS_SV) + (size_t)layer * NEXP;
    const unsigned short* IDX = (const unsigned short*)(F.ws + WS_IDX); const float* GATE = (const float*)(F.ws + WS_GATE);
    const float* gn = F.in[7] + (size_t)layer * DM;
    float* ACT = (float*)(F.ws + WS_ACTG);
    const float* gnext = F.in[1] + (size_t)(layer + 1 < DEPTH ? layer + 1 : 0) * DM;
    const int lane = F.lane, k = lane & 31, hf = lane >> 5;
    const int b3 = lane & 8, b2 = lane & 4, b1 = lane & 2;
    for (int tok = F.gw; tok < MTOK; tok += F.NGW) {
        bf16_t* xr = (bf16_t*)(F.ws + WS_X1B) + (size_t)tok * DM + 4 * k;
        f32x32 xh;
        {   float ss = 0.f;
#pragma unroll
            for (int i = 0; i < 8; ++i) { const u32x2 t2 = *(const u32x2*)(xr + 128 * i); const f32x4 t = {bf_lo(t2.x), bf_hi(t2.x), bf_lo(t2.y), bf_hi(t2.y)}; xh[4 * i] = t.x; xh[4 * i + 1] = t.y; xh[4 * i + 2] = t.z; xh[4 * i + 3] = t.w; ss += (t.x * t.x + t.y * t.y) + (t.z * t.z + t.w * t.w); }
            ss += dppf<DPP_XOR1>(ss); ss += dppf<DPP_XOR2>(ss); ss += dppf<DPP_HMIR>(ss); ss += dppf<DPP_RMIR>(ss); ss = swap16_sum(ss, ss);
            const float rs = rsqrtf(ss * (1.0f / DM) + EPS);
#pragma unroll
            for (int i = 0; i < 8; ++i) { const f32x4 g = *(const f32x4*)(gn + 4 * k + 128 * i); xh[4 * i] *= rs * g.x; xh[4 * i + 1] *= rs * g.y; xh[4 * i + 2] *= rs * g.z; xh[4 * i + 3] *= rs * g.w; } }
        const unsigned idxreg = ((const unsigned*)(IDX + (size_t)tok * 128))[lane];
        const int s0 = 2 * (16 * (k & 1) + (k >> 1)) + hf, s1 = 64 + s0;
        const unsigned e0 = IDX[(size_t)tok * 128 + s0], e1 = IDX[(size_t)tok * 128 + s1];
        const float gate0 = GATE[(size_t)tok * 128 + s0] * SV[e0], gate1 = GATE[(size_t)tok * 128 + s1] * SV[e1];
        const float su0 = SU[e0], su1 = SU[e1];
        float z0 = 0.f, z1 = 0.f;
#define G_LOAD(W_, T_, qb) do { _Pragma("unroll") for (int j = 0; j < 8; ++j) { \
            const unsigned wv = (unsigned)__builtin_amdgcn_readlane((int)idxreg, (qb) + j); const unsigned e = hf ? (wv >> 16) : (wv & 0xffffu); \
            W_[j] = *(const u32x6_a8*)(T_ + (size_t)e * ROWB + 24 * k); } } while (0)
#define G_UDOT(W_, P_, po) do { _Pragma("unroll") for (int j = 0; j < 8; ++j) { \
            const f32x32 d = __builtin_amdgcn_cvt_scalef32_pk32_f32_fp6(W_[j], 1.0f); f32x2_t ac[4]; \
            _Pragma("unroll") for (int c = 0; c < 4; ++c) ac[c] = (f32x2_t){d[2 * c], d[2 * c + 1]} * (f32x2_t){xh[2 * c], xh[2 * c + 1]}; \
            _Pragma("unroll") for (int i = 8; i < 32; i += 2) ac[(i >> 1) & 3] = (f32x2_t){d[i], d[i + 1]} * (f32x2_t){xh[i], xh[i + 1]} + ac[(i >> 1) & 3]; \
            const f32x2_t as_ = (ac[0] + ac[1]) + (ac[2] + ac[3]); P_[(po) + j] = as_.x + as_.y; } } while (0)
#define G_VACC(W_, qb) do { const float asel = ((qb) < 32) ? act0 : act1; _Pragma("unroll") for (int j = 0; j < 8; ++j) { \
            const int al_ = 2 * (((qb) + j) & 15) + ((((qb) + j) >> 4) & 1); \
            const float alo = __uint_as_float((unsigned)__builtin_amdgcn_readlane((int)__float_as_uint(asel), al_)); \
            const float ahi = __uint_as_float((unsigned)__builtin_amdgcn_readlane((int)__float_as_uint(asel), 32 + al_)); \
            const float a = hf ? ahi : alo; const f32x32 d = __builtin_amdgcn_cvt_scalef32_pk32_f32_fp6(W_[j], 1.0f); o = d * a + o; } } while (0)
        u32x6 wA[8], wB[8];
        if (PART == 0) {
            G_LOAD(wA, Ut, 0);
#pragma unroll 1
            for (int q0 = 0; q0 < 64; q0 += 16) {
                float p[16];
                G_LOAD(wB, Ut, q0 + 8);
                G_UDOT(wA, p, 0);
                if (q0 + 16 < 64) G_LOAD(wA, Ut, q0 + 16);
                G_UDOT(wB, p, 8);
                float q8[8], q4[4], q2[2];
#pragma unroll
                for (int j = 0; j < 8; ++j) q8[j] = swap16_sum(p[j], p[j + 8]);
#pragma unroll
                for (int j = 0; j < 4; ++j) { const float send = b3 ? q8[j] : q8[j + 4], keep = b3 ? q8[j + 4] : q8[j]; q4[j] = keep + dppf<DPP_RMIR>(send); }
#pragma unroll
                for (int j = 0; j < 2; ++j) { const float send = b2 ? q4[j] : q4[j + 2], keep = b2 ? q4[j + 2] : q4[j]; q2[j] = keep + dppf<DPP_HMIR>(send); }
                float pz;
                { const float send = b1 ? q2[0] : q2[1], keep = b1 ? q2[1] : q2[0]; pz = keep + dppf<DPP_XOR2>(send); }
                pz += dppf<DPP_XOR1>(pz);
                if ((k & 1) == ((q0 >> 4) & 1)) { if (q0 < 32) z0 = pz; else z1 = pz; }
            }
        }
        z0 *= su0; z1 *= su1;
        float act0, act1;
        if (PART == 0) { act0 = 0.5f * z0 * (1.0f + erff(z0 * 0.70710678118654752f)) * gate0; act1 = 0.5f * z1 * (1.0f + erff(z1 * 0.70710678118654752f)) * gate1; }
        else { act0 = ACT[(size_t)tok * 128 + s0]; act1 = ACT[(size_t)tok * 128 + s1]; }
        if (PART == 0) { ACT[(size_t)tok * 128 + s0] = act0; ACT[(size_t)tok * 128 + s1] = act1; continue; }
        f32x32 o;
#pragma unroll
        for (int i = 0; i < 32; ++i) o[i] = 0.f;
        G_LOAD(wA, Vt, 0);
#pragma unroll 1
        for (int q0 = 0; q0 < 64; q0 += 16) {
            G_LOAD(wB, Vt, q0 + 8);
            G_VACC(wA, q0);
            if (q0 + 16 < 64) G_LOAD(wA, Vt, q0 + 16);
            G_VACC(wB, q0 + 8);
        }
#undef G_LOAD
#undef G_UDOT
#undef G_VACC
        float xn[16]; float s2 = 0.f;
#pragma unroll
        for (int i = 0; i < 16; ++i) {
            const float tot = swap32_sum(o[i], o[i + 16]);
            xn[i] = tot;
        }
        bf16_t* xw = xr + 512 * hf;
#pragma unroll
        for (int i = 0; i < 4; ++i) { const u32x2 t2 = *(const u32x2*)(xw + 128 * i); xn[4 * i] += bf_lo(t2.x); xn[4 * i + 1] += bf_hi(t2.x); xn[4 * i + 2] += bf_lo(t2.y); xn[4 * i + 3] += bf_hi(t2.y); }
        if (layer + 1 < DEPTH) {
#pragma unroll
            for (int i = 0; i < 4; ++i) { u32x2 w; w.x = cvtpk(xn[4 * i], xn[4 * i + 1]); w.y = cvtpk(xn[4 * i + 2], xn[4 * i + 3]); *(u32x2*)(xw + 128 * i) = w; }
        } else {
            float* ow = F.out + (size_t)tok * DM + 4 * k + 512 * hf;
#pragma unroll
            for (int i = 0; i < 4; ++i) *(f32x4*)(ow + 128 * i) = (f32x4){xn[4 * i], xn[4 * i + 1], xn[4 * i + 2], xn[4 * i + 3]};
        }
        if (layer + 1 < DEPTH) {
#pragma unroll
            for (int i = 0; i < 16; ++i) s2 += xn[i] * xn[i];
            const float rs2 = rsqrtf(wave_sum(s2) * (1.0f / DM) + EPS);
            const float* gp = gnext + 4 * k + 512 * hf;
            bf16_t* hr = (bf16_t*)(F.ws + WS_H) + (size_t)tok * DM + 4 * k + 512 * hf;
#pragma unroll
            for (int i = 0; i < 4; ++i) { const f32x4 g = *(const f32x4*)(gp + 128 * i);
                u32x2 w; w.x = cvtpk(xn[4 * i] * rs2 * g.x, xn[4 * i + 1] * rs2 * g.y); w.y = cvtpk(xn[4 * i + 2] * rs2 * g.z, xn[4 * i + 3] * rs2 * g.w);
                *(u32x2*)(hr + 128 * i) = w; }
        }
    }
}

#define GAS __attribute__((address_space(1)))
#define XB_TMO      128
#define XB_XCNT(j)  (256  + 64 * (j))
#define XB_XSUB(j)  (1280 + 64 * (j))
#define XB_XGEN(j)  (2304 + 64 * (j))
#define XB_TOP      3328
#define XB_TOPGEN   3392
#define XCD_BAR_WORDS 3456
#define XB_SPIN_CAP (1u << 18)

__device__ __forceinline__ unsigned xb_ld(unsigned* p)              { return __hip_atomic_load(p, __ATOMIC_RELAXED, __HIP_MEMORY_SCOPE_AGENT); }
__device__ __forceinline__ unsigned xb_add(unsigned* p, unsigned v) { return __hip_atomic_fetch_add(p, v, __ATOMIC_RELAXED, __HIP_MEMORY_SCOPE_AGENT); }
__device__ __forceinline__ unsigned xb_xcc_id() { return (unsigned)__builtin_amdgcn_s_getreg((3 << 11) | 20) & 0xFu; }
#define XB_SPIN(cond, bar) do { unsigned _sp = 0; while (cond) { __builtin_amdgcn_s_sleep(1); \
    if ((++_sp & 255u) == 0u) { if (xb_ld(&(bar)[XB_TMO])) break; if (_sp > XB_SPIN_CAP) { atomicAdd(&(bar)[XB_TMO], 1u); break; } } } } while (0)

struct XcdBarrier {
    unsigned* bar; unsigned x;
    volatile LAS unsigned* st;
};

__device__ __forceinline__ XcdBarrier xcd_barrier_post(unsigned* bar, volatile LAS unsigned* st) {
    XcdBarrier b; b.bar = bar; b.x = xb_xcc_id(); b.st = st;
    if (threadIdx.x == 0) (void)xb_add(&bar[XB_XCNT(b.x)], 1u);
    return b;
}
__device__ __forceinline__ void xcd_barrier_complete(unsigned* bar, unsigned x, unsigned& nloc, unsigned& nx) {
    const unsigned G = gridDim.x * gridDim.y * gridDim.z;
    unsigned sum, cnt, mine, sp = 0u;
    for (;;) {
        sum = 0u; cnt = 0u; mine = 0u;
#pragma unroll
        for (unsigned j = 0; j < 16; ++j) { const unsigned c = xb_ld(&bar[XB_XCNT(j)]); sum += c; cnt += (c > 0u) ? 1u : 0u; mine = (j == x) ? c : mine; }
        if (sum == G) break;
        __builtin_amdgcn_s_sleep(1);
        if ((++sp & 255u) == 0u) { if (xb_ld(&bar[XB_TMO])) break; if (sp > XB_SPIN_CAP) { atomicAdd(&bar[XB_TMO], 1u); break; } }
    }
    nloc = mine > 0u ? mine : 1u; nx = cnt > 0u ? cnt : 1u;
}

__device__ __forceinline__ void xcd_barrier(const XcdBarrier& b) {
    asm volatile("s_waitcnt vmcnt(0)" ::: "memory");
    __syncthreads();
    if (threadIdx.x == 0) {
        unsigned* bar = b.bar;
        __builtin_amdgcn_s_waitcnt(0);
        unsigned nloc = b.st[0], nx = b.st[1];
        if (nloc == 0u) { xcd_barrier_complete(bar, b.x, nloc, nx); b.st[0] = nloc; b.st[1] = nx; }
        const unsigned old = xb_add(&bar[XB_XSUB(b.x)], 1u);
        const unsigned gen = old / nloc;
        if (old + 1u == (gen + 1u) * nloc) {
            __builtin_amdgcn_fence(__ATOMIC_RELEASE, "agent");
            asm volatile("s_waitcnt vmcnt(0)" ::: "memory");
            const unsigned og = xb_add(&bar[XB_TOP], 1u);
            const unsigned tg = og / nx;
            if (og + 1u == (tg + 1u) * nx) xb_add(&bar[XB_TOPGEN], 1u);
            else XB_SPIN(xb_ld(&bar[XB_TOPGEN]) == tg, bar);
            __builtin_amdgcn_fence(__ATOMIC_ACQUIRE, "agent");
            xb_add(&bar[XB_XGEN(b.x)], 1u);
            asm volatile("s_waitcnt vmcnt(0)" ::: "memory");
        } else {
            XB_SPIN(xb_ld(&bar[XB_XGEN(b.x)]) == gen, bar);
            __builtin_amdgcn_fence(__ATOMIC_ACQUIRE, "agent");
            asm volatile("s_waitcnt vmcnt(0)" ::: "memory");
        }
    }
    __syncthreads();
}

constexpr int PH_PER_LAYER = 9;
constexpr int N_PHASES = 1 + PH_PER_LAYER * DEPTH;
struct Args { const float* in[12]; float* out; unsigned char* ws; int ph_lo, ph_hi; };
__global__ void __launch_bounds__(NTHREADS, 2) mk_fwd(Args args) {
    extern __shared__ __attribute__((aligned(16))) unsigned char lds_raw[];
#define MKCTX() Ctx F; { int t_ = threadIdx.x, b_ = blockIdx.x; asm volatile("" : "+v"(t_)); asm volatile("" : "+s"(b_)); \
        F.lds = (LAS unsigned char*)lds_raw; F.tid = t_; F.lane = t_ & 63; F.wave = __builtin_amdgcn_readfirstlane(t_ >> 6); F.G = gridDim.x; \
        F.vcu = (F.G % 8 == 0) ? (b_ % 8) * (F.G / 8) + b_ / 8 : b_; F.gw = F.vcu * NWAVES + F.wave; F.NGW = F.G * NWAVES; F.in = args.in; F.out = args.out; F.ws = args.ws; }
    const int lo = args.ph_lo, hi = args.ph_hi;
    volatile LAS unsigned* MISC = (volatile LAS unsigned*)((LAS unsigned char*)lds_raw + 131072);
    if (threadIdx.x < 16) MISC[threadIdx.x] = 0u;
    __syncthreads();
    XcdBarrier bar = xcd_barrier_post((unsigned*)(args.ws + WS_CTL) + 4096, MISC + 8);
#define IN(k) (lo <= (k) && (k) < hi)
#define SEAM(k) do { if (IN(k) && IN((k) + 1)) { if ((k) == 0) cg::this_grid().sync(); else xcd_barrier(bar); } } while (0)
#ifndef DUP_PH
#define DUP_PH -1
#endif
#define PH(k, kk, ...) do { if (IN(k)) { __VA_ARGS__; if (DUP_PH == (kk)) { xcd_barrier(bar); __VA_ARGS__; } } SEAM(k); } while (0)
    PH(0, 0, { MKCTX(); phase_p0(F); });
#pragma unroll 1
    for (int l = 0; l < DEPTH; ++l) {
        const int pb = 1 + PH_PER_LAYER * l;
        bf16_t* H = (bf16_t*)(args.ws + WS_H);
        PH(pb + 0, 1, {
            pg8::Gemm g{H, (const bf16_t*)(args.ws + WS_WIN) + (size_t)l * PW * DM, MTOK, PW, DM}; pg8::StaticOrder S; S.init(MTOK, PW, (int)gridDim.x, (int)blockIdx.x);
            pg8::EpiBf16 E{(bf16_t*)(args.ws + WS_P), PW};
            pg8::gemm_phase<pg8::EpiBf16, pg8::StaticOrder, true, true>((LAS unsigned char*)lds_raw, g, S, E); });
        PH(pb + 1, -2, { MKCTX(); phase_rope(F, F.in[3] + l * 384); });
        PH(pb + 2, 3, { MKCTX(); phase_attn(F, F.in[4] + l * 4, F.in[3] + l * 384); });
        PH(pb + 3, 4, { MKCTX(); phase_post(F, F.in[5] + l * DM); });
        PH(pb + 4, -2, {
            pg8::Gemm g{H, (const bf16_t*)(args.ws + WS_WOUT) + (size_t)l * DM * DM, MTOK, DM, DM}; pg8::StaticOrder S; S.init(MTOK, DM, (int)gridDim.x, (int)blockIdx.x);
            bf16_t* XB = (bf16_t*)(args.ws + WS_X1B); float* SQ = (float*)(args.ws + WS_SSQ) + (size_t)l * MTOK * 16;
            if (l == 0) { pg8::EpiResBf16<true> E{(const void*)args.in[0], XB, SQ, DM}; pg8::gemm_phase<pg8::EpiResBf16<true>, pg8::StaticOrder, true, true>((LAS unsigned char*)lds_raw, g, S, E); }
            else { pg8::EpiResBf16<false> E{(const void*)XB, XB, SQ, DM}; pg8::gemm_phase<pg8::EpiResBf16<false>, pg8::StaticOrder, true, true>((LAS unsigned char*)lds_raw, g, S, E); } });
        PH(pb + 5, 7, {
            pg8::Gemm g{(const bf16_t*)(args.ws + WS_X1B), (const bf16_t*)(args.ws + WS_WQ) + (size_t)l * DM * DM, MTOK, DM, DM}; pg8::StaticOrder S; S.init(MTOK, DM, (int)gridDim.x, (int)blockIdx.x);
            pg8::EpiBf16 E{(bf16_t*)(args.ws + WS_Q), DM};
            pg8::gemm_phase<pg8::EpiBf16, pg8::StaticOrder, true, true>((LAS unsigned char*)lds_raw, g, S, E); });
        PH(pb + 6, 8, { MKCTX(); phase_route(F, l); });
        PH(pb + 7, -2, { MKCTX(); phase_gather<0>(F, l); });
        PH(pb + 8, -2, { MKCTX(); phase_gather<1>(F, l); });
    }
#undef IN
#undef SEAM
}

#ifndef MK_ONE_LAUNCH
#define MK_ONE_LAUNCH 1
#endif
extern "C" void kernel_launch(void* const* d_in, const int* in_sizes, int n_in, void* d_out, int out_size, void* d_ws, size_t ws_size, hipStream_t stream) {
    static int grid = 0;
    if (grid == 0) {
        if (n_in != 12 || ws_size < WS_END) { fprintf(stderr, "kernel_launch: unexpected n_in %d / ws %zu\n", n_in, ws_size); grid = -1; return; }
        int dev = 0, cus = 0, per_cu = 0;
        if (hipGetDevice(&dev) != hipSuccess || hipDeviceGetAttribute(&cus, hipDeviceAttributeMultiprocessorCount, dev) != hipSuccess) { grid = -1; return; }
        if (hipFuncSetAttribute((const void*)mk_fwd, hipFuncAttributeMaxDynamicSharedMemorySize, LDS_BYTES) != hipSuccess) { fprintf(stderr, "kernel_launch: hipFuncSetAttribute failed\n"); grid = -1; return; }
        if (hipOccupancyMaxActiveBlocksPerMultiprocessor(&per_cu, (const void*)mk_fwd, NTHREADS, LDS_BYTES) != hipSuccess || per_cu < 1) { fprintf(stderr, "kernel_launch: occupancy query failed (%d)\n", per_cu); (void)hipGetLastError(); grid = -1; return; }
        grid = cus * per_cu;
        fprintf(stderr, "kernel_launch: cus %d per_cu %d grid %d\n", cus, per_cu, grid);
    }
    if (grid < 0) return;
    if (hipMemsetAsync((char*)d_ws + WS_CTL, 0, CTL_BYTES, stream) != hipSuccess) { fprintf(stderr, "kernel_launch: memset failed\n"); return; }
    Args a{};
    for (int i = 0; i < 12; ++i) a.in[i] = (const float*)d_in[i];
    a.out = (float*)d_out; a.ws = (unsigned char*)d_ws;
#if MK_ONE_LAUNCH
    a.ph_lo = 0; a.ph_hi = N_PHASES;
    void* kargs[] = {&a};
    hipError_t e = hipLaunchCooperativeKernel((const void*)mk_fwd, dim3(grid), dim3(NTHREADS), kargs, LDS_BYTES, stream);
    if (e != hipSuccess) fprintf(stderr, "cooperative launch failed: %s (grid %d)\n", hipGetErrorString(e), grid);
#else
    for (int p = 0; p < N_PHASES; ++p) { a.ph_lo = p; a.ph_hi = p + 1; hipLaunchKernelGGL(mk_fwd, dim3(grid), dim3(NTHREADS), LDS_BYTES, stream, a); }
#endif
}
```
